# Optimizing an MI355X kernel written in HIP

```python
import jax, jax.numpy as jnp
from jax import lax
import numpy as np

D_MODEL = 2048
BATCH = 1
SEQ = 8192
DEPTH = 2

N_META = 16
EPS = 1e-6
D_FF = -(-(8 * D_MODEL) // (3 * 256)) * 256
N_A_LAYERS = (DEPTH + 1) // 2
N_C_LAYERS = DEPTH // 2
D_A = D_MODEL // 2
HGRN_HEAD = 128
HGRN_HEADS = D_A // HGRN_HEAD
CHUNK = 64
D_B = D_MODEL - D_A
SCONV_W = 3
D_C = D_MODEL // 2
RG_BLOCKS = 8
RG_BLOCK = D_C // RG_BLOCKS
RG_CONV_W = 4
RG_C = 8.0
ATT_HEADS = 8
ATT_HEAD_DIM = 128
D_D = ATT_HEADS * ATT_HEAD_DIM
KV_RANK = 256
IDX_HEADS = 16
IDX_DIM = 64
TOPK_MAX = 256
Q_BLOCK = 128

AB_SIZES = [D_A, D_A, D_A, D_A, D_B, D_B, D_B]
CD_SIZES = [D_C, D_C, D_D, KV_RANK, IDX_HEADS * IDX_DIM, IDX_DIM, IDX_HEADS]

kernel_name = 'hybrid_hgrn2_sconv_rglru_dsa_block'


def rms_norm(x, g):
    xf = x.astype(jnp.float32)
    y = xf * lax.rsqrt(jnp.mean(xf * xf, axis=-1, keepdims=True) + EPS)
    return (y * g.astype(jnp.float32)).astype(x.dtype)


def split_cols(a, sizes):
    idx = [int(v) for v in np.cumsum(sizes)[:-1]]
    return jnp.split(a, idx, axis=-1)


def causal_depthwise_conv(u, w):
    K = w.shape[0]
    return lax.conv_general_dilated(
        u, w[:, None, :].astype(u.dtype), window_strides=(1,), padding=[(K - 1, 0)],
        dimension_numbers=('NWC', 'WIO', 'NWC'), feature_group_count=u.shape[-1])


def hgrn2_chunked(q, f_logit, v, lb):
    B, T, H, dk = q.shape
    dv = v.shape[-1]
    f32 = jnp.float32
    f = lb + (1.0 - lb) * jax.nn.sigmoid(f_logit.astype(f32))
    log_f = jnp.log(f)
    k = 1.0 - f
    pad = (-N_META) % CHUNK
    padf = lambda a: jnp.pad(a.astype(f32), ((0, 0), (pad, 0), (0, 0), (0, 0)))
    q, k, v, log_f = padf(q), padf(k), padf(v), padf(log_f)
    n = (T + pad) // CHUNK
    chunks = lambda a: a.reshape(B, n, CHUNK, H, a.shape[-1]).transpose(1, 0, 3, 2, 4)
    tri = jnp.tril(jnp.ones((CHUNK, CHUNK), bool))[:, :, None]

    def step(S, xs):
        qc, kc, vc, lfc = xs
        b = jnp.cumsum(lfc, axis=2)
        inter = jnp.einsum('bhtk,bhkv->bhtv', qc * jnp.exp(b), S)
        diff = b[:, :, :, None, :] - b[:, :, None, :, :]
        decay = jnp.where(tri, jnp.exp(jnp.where(tri, diff, 0.0)), 0.0)
        att = jnp.einsum('bhtsk,bhsk->bhts', qc[:, :, :, None, :] * decay, kc)
        intra = jnp.einsum('bhts,bhsv->bhtv', att, vc)
        b_last = b[:, :, -1:, :]
        S_new = jnp.exp(b_last[:, :, 0, :])[..., None] * S + jnp.einsum(
            'bhsk,bhsv->bhkv', kc * jnp.exp(b_last - b), vc)
        return S_new, inter + intra

    S0 = jnp.zeros((B, H, dk, dv), f32)
    _, o = lax.scan(step, S0, (chunks(q), chunks(k), chunks(v), chunks(log_f)))
    o = o.transpose(1, 0, 3, 2, 4).reshape(B, n * CHUNK, H, dv)
    return o[:, pad:]


def rg_lru(u, w_a, b_a, w_i, b_i, lam):
    B, T, _ = u.shape
    f32 = jnp.float32
    ub = u.reshape(B, T, RG_BLOCKS, RG_BLOCK)
    r = jax.nn.sigmoid(jnp.einsum('btnc,ncd->btnd', ub, w_a.astype(f32)).reshape(B, T, D_C) + b_a.astype(f32))
    ig = jax.nn.sigmoid(jnp.einsum('btnc,ncd->btnd', ub, w_i.astype(f32)).reshape(B, T, D_C) + b_i.astype(f32))
    log_a = -RG_C * r * jax.nn.softplus(-lam.astype(f32))
    a = jnp.exp(log_a)
    xin = jnp.sqrt(-jnp.expm1(2.0 * log_a)) * (ig * u)

    def comb(left, right):
        a1, b1 = left
        a2, b2 = right
        return a1 * a2, a2 * b1 + b2

    _, h = lax.associative_scan(comb, (a, xin), axis=1)
    return h


def dsa_attention(q, ckv, iq, ik, iw, w_uk, w_uv):
    B, T = q.shape[0], q.shape[1]
    f32 = jnp.float32
    m = N_META
    L = T - m
    k_sel = min(TOPK_MAX, L // 4)
    n_blk = L // Q_BLOCK
    q_lat = jnp.einsum('bthd,rhd->bthr', q, w_uk) * (ATT_HEAD_DIM ** -0.5)
    c_meta, c_real = ckv[:, :m], ckv[:, m:]
    ik_real = ik[:, m:].astype(f32)
    tri = jnp.tril(jnp.ones((m, m), bool))
    s_mm = jnp.einsum('bqhr,bsr->bqhs', q_lat[:, :m], c_meta).astype(f32)
    p_mm = jax.nn.softmax(jnp.where(tri[None, :, None, :], s_mm, -jnp.inf), axis=-1).astype(ckv.dtype)
    o_meta = jnp.einsum('bqhs,bsr->bqhr', p_mm, c_meta)
    s_pos = jnp.arange(L)
    bidx = jnp.arange(B)[:, None, None]

    def to_blocks(a):
        return a[:, m:].reshape((B, n_blk, Q_BLOCK) + a.shape[2:]).swapaxes(0, 1)

    def block(args):
        ql, iqb, iwb, start = args
        t_pos = start + jnp.arange(Q_BLOCK)
        rel = jax.nn.relu(jnp.einsum('bqhd,bsd->bqhs', iqb.astype(f32), ik_real) * (IDX_DIM ** -0.5))
        score = jnp.einsum('bqhs,bqh->bqs', rel, iwb.astype(f32) * (IDX_HEADS ** -0.5))
        score = jnp.where((s_pos[None, :] <= t_pos[:, None])[None], score, -jnp.inf)
        _, idx = lax.top_k(score, k_sel)
        valid = idx <= t_pos[None, :, None]
        c_sel = c_real[bidx, idx]
        s_meta = jnp.einsum('bqhr,bmr->bqhm', ql, c_meta).astype(f32)
        s_sel = jnp.einsum('bqhr,bqkr->bqhk', ql, c_sel).astype(f32)
        s_all = jnp.concatenate([s_meta, jnp.where(valid[:, :, None, :], s_sel, -jnp.inf)], axis=-1)
        p = jax.nn.softmax(s_all, axis=-1).astype(ql.dtype)
        return (jnp.einsum('bqhm,bmr->bqhr', p[..., :m], c_meta)
                + jnp.einsum('bqhk,bqkr->bqhr', p[..., m:], c_sel))

    starts = jnp.arange(n_blk, dtype=jnp.int32) * Q_BLOCK
    o_blk = lax.map(block, (to_blocks(q_lat), to_blocks(iq), to_blocks(iw), starts))
    o_real = o_blk.swapaxes(0, 1).reshape(B, L, ATT_HEADS, KV_RANK)
    o_lat = jnp.concatenate([o_meta, o_real], axis=1)
    return jnp.einsum('bthr,rhd->bthd', o_lat, w_uv)


def mixer_ab(h, w_in, w_out, lb, out_norm_g, sconv_w):
    B, T, _ = h.shape
    q, f, i, g, sx, sb, sc = split_cols(h @ w_in, AB_SIZES)
    hd = lambda a: a.reshape(B, T, HGRN_HEADS, HGRN_HEAD)
    o = hgrn2_chunked(hd(q), hd(f), hd(i), lb.reshape(HGRN_HEADS, HGRN_HEAD))
    o = rms_norm(o, out_norm_g).reshape(B, T, D_A).astype(h.dtype) * jax.nn.silu(g)
    yb = sb * causal_depthwise_conv(sc * sx, sconv_w)
    return jnp.concatenate([o, yb], axis=-1) @ w_out


def mixer_cd(h, w_in, w_out, conv_w, conv_b, w_a, b_a, w_i, b_i, lam, kv_norm_g, w_uk, w_uv):
    B, T, _ = h.shape
    rx, ry, q, ckv, iq, ik, iw = split_cols(h @ w_in, CD_SIZES)
    u = causal_depthwise_conv(rx, conv_w) + conv_b
    hc = rg_lru(u.astype(jnp.float32), w_a, b_a, w_i, b_i, lam).astype(h.dtype) * jax.nn.gelu(ry)
    att = dsa_attention(q.reshape(B, T, ATT_HEADS, ATT_HEAD_DIM), rms_norm(ckv, kv_norm_g),
                        iq.reshape(B, T, IDX_HEADS, IDX_DIM), ik, iw, w_uk, w_uv)
    return jnp.concatenate([hc, att.reshape(B, T, D_D)], axis=-1) @ w_out


def swiglu(h, w1, w3, w2):
    return (jax.nn.silu(h @ w1) * (h @ w3)) @ w2


def setup_inputs(seed: int = 0) -> dict:
    key = jax.random.key(seed)
    ks = iter(jax.random.split(key, 40))
    f32 = jnp.float32
    nrm = lambda shape, scale: jax.random.normal(next(ks), shape, f32) * scale
    gain = lambda shape: 1.0 + 0.05 * jax.random.normal(next(ks), shape, f32)
    u = jax.random.uniform(next(ks), (N_C_LAYERS, D_C), f32, minval=0.9, maxval=0.999)
    s = u ** (1.0 / RG_C)
    return {
        'x': nrm((BATCH, SEQ, D_MODEL), 1.0),
        'meta_tokens': nrm((N_META, D_MODEL), 1.0),
        'ln_mix_pre': gain((DEPTH, D_MODEL)),
        'ln_mix_post': gain((DEPTH, D_MODEL)),
        'ln_ffn_pre': gain((DEPTH, D_MODEL)),
        'ln_ffn_post': gain((DEPTH, D_MODEL)),
        'ffn_w1': nrm((DEPTH, D_MODEL, D_FF), D_MODEL ** -0.5),
        'ffn_w3': nrm((DEPTH, D_MODEL, D_FF), D_MODEL ** -0.5),
        'ffn_w2': nrm((DEPTH, D_FF, D_MODEL), D_FF ** -0.5),
        'ab_w_in': nrm((N_A_LAYERS, D_MODEL, sum(AB_SIZES)), D_MODEL ** -0.5),
        'ab_w_out': nrm((N_A_LAYERS, D_A + D_B, D_MODEL), (D_A + D_B) ** -0.5),
        'hgrn_lb_logits': nrm((N_A_LAYERS + 1, D_A), 0.5),
        'hgrn_out_norm': gain((N_A_LAYERS, HGRN_HEAD)),
        'sconv_w': nrm((N_A_LAYERS, SCONV_W, D_B), SCONV_W ** -0.5),
        'cd_w_in': nrm((N_C_LAYERS, D_MODEL, sum(CD_SIZES)), D_MODEL ** -0.5),
        'cd_w_out': nrm((N_C_LAYERS, D_C + D_D, D_MODEL), (D_C + D_D) ** -0.5),
        'rg_conv_w': nrm((N_C_LAYERS, RG_CONV_W, D_C), RG_CONV_W ** -0.5),
        'rg_conv_b': nrm((N_C_LAYERS, D_C), 0.01),
        'rg_w_a': nrm((N_C_LAYERS, RG_BLOCKS, RG_BLOCK, RG_BLOCK), RG_BLOCK ** -0.5),
        'rg_b_a': nrm((N_C_LAYERS, D_C), 0.01),
        'rg_w_i': nrm((N_C_LAYERS, RG_BLOCKS, RG_BLOCK, RG_BLOCK), RG_BLOCK ** -0.5),
        'rg_b_i': nrm((N_C_LAYERS, D_C), 0.01),
        'rg_lambda': jnp.log(s) - jnp.log1p(-s),
        'mla_kv_norm': gain((N_C_LAYERS, KV_RANK)),
        'mla_w_uk': nrm((N_C_LAYERS, KV_RANK, ATT_HEADS, ATT_HEAD_DIM), KV_RANK ** -0.5),
        'mla_w_uv': nrm((N_C_LAYERS, KV_RANK, ATT_HEADS, ATT_HEAD_DIM), KV_RANK ** -0.5),
    }


def reference(x, meta_tokens, ln_mix_pre, ln_mix_post, ln_ffn_pre, ln_ffn_post, ffn_w1, ffn_w3, ffn_w2,
              ab_w_in, ab_w_out, hgrn_lb_logits, hgrn_out_norm, sconv_w,
              cd_w_in, cd_w_out, rg_conv_w, rg_conv_b, rg_w_a, rg_b_a, rg_w_i, rg_b_i, rg_lambda,
              mla_kv_norm, mla_w_uk, mla_w_uv):
    B = x.shape[0]
    meta = jnp.broadcast_to(meta_tokens.astype(x.dtype)[None], (B, N_META, x.shape[-1]))
    h = jnp.concatenate([meta, x], axis=1)
    lb_all = jnp.cumsum(jax.nn.softmax(hgrn_lb_logits.astype(jnp.float32), axis=0), axis=0)
    for l in range(DEPTH):
        j = l // 2
        hn = rms_norm(h, ln_mix_pre[l])
        if l % 2 == 0:
            mix = mixer_ab(hn, ab_w_in[j], ab_w_out[j], lb_all[j], hgrn_out_norm[j], sconv_w[j])
        else:
            mix = mixer_cd(hn, cd_w_in[j], cd_w_out[j], rg_conv_w[j], rg_conv_b[j], rg_w_a[j], rg_b_a[j],
                           rg_w_i[j], rg_b_i[j], rg_lambda[j], mla_kv_norm[j], mla_w_uk[j], mla_w_uv[j])
        h = h + rms_norm(mix, ln_mix_post[l])
        hn = rms_norm(h, ln_ffn_pre[l])
        h = h + rms_norm(swiglu(hn, ffn_w1[l], ffn_w3[l], ffn_w2[l]), ln_ffn_post[l])
    return h[:, N_META:]
```

```cpp
#include <hip/hip_runtime.h>
#include <hip/hip_cooperative_groups.h>
#include <cstdio>
#include <cstdint>
namespace cg = cooperative_groups;

#define LAS __attribute__((address_space(3)))
typedef unsigned short bf16_t;
typedef short bf16x8 __attribute__((ext_vector_type(8)));
typedef float f32x4 __attribute__((ext_vector_type(4)));
typedef float f32x2 __attribute__((ext_vector_type(2)));
typedef unsigned u32x4 __attribute__((ext_vector_type(4)));
typedef unsigned u32x2 __attribute__((ext_vector_type(2)));

constexpr int NREAL = 8192, NMETA = 16, NTOK = 8208, ROWS = 8448, DM = 2048, DFF = 5632;
constexpr int N_AB = 7168, N_CD = 4432, N_CDP = 4608;
constexpr float EPS = 1e-6f;
constexpr int NTHR = 512, NWAVES = 8;

constexpr size_t WS_CTL = 0;
constexpr size_t WS_RS = 65536;
constexpr size_t WS_W = 1u << 20;
constexpr size_t W_IN = 0, W_OUT = 29360128, W_13 = 37748736, W_2 = 83886080, W_BYTES = 106954752;
constexpr size_t WS_H = WS_W + W_BYTES;
constexpr size_t WS_HN = WS_H + (size_t)ROWS * DM * 4;
constexpr size_t WS_C = WS_HN + (size_t)ROWS * DM * 2;
constexpr size_t WS_IDX = WS_C + (size_t)ROWS * 256 * 2;
constexpr size_t WS_BIG = WS_IDX + (size_t)NREAL * 256 * 4;
constexpr size_t B_PROJ = 0, B_ACT = 0;
constexpr size_t B_Y = (size_t)ROWS * N_AB * 2;
constexpr size_t B_HO = B_Y;
constexpr size_t B_L1 = (size_t)ROWS * N_CDP * 2;
constexpr size_t B_U = B_L1, B_A = B_U + (size_t)ROWS * 1024 * 4, B_X = B_A + (size_t)ROWS * 1024 * 4;
constexpr size_t B_SC = B_L1;
constexpr size_t B_OL = B_L1 + (size_t)ROWS * DM * 2;
constexpr size_t WS_QL = WS_H + (size_t)ROWS * DM * 2;
constexpr size_t SC_BYTES = (size_t)16384 * 2080 * 4;
constexpr size_t BIG_BYTES = B_SC + SC_BYTES;
constexpr size_t WS_GM = WS_BIG + BIG_BYTES;
constexpr size_t WS_END = WS_GM + (size_t)NREAL * 1024 * 2;

struct Params { const float* in[26]; float* out; unsigned char* ws; };
enum { I_X = 0, I_META, I_LN_MIX_PRE, I_LN_MIX_POST, I_LN_FFN_PRE, I_LN_FFN_POST, I_W1, I_W3, I_W2, I_AB_IN, I_AB_OUT, I_LB, I_HG_NORM, I_SCONV,
       I_CD_IN, I_CD_OUT, I_RG_CW, I_RG_CB, I_RG_WA, I_RG_BA, I_RG_WI, I_RG_BI, I_RG_LAM, I_KVN, I_WUK, I_WUV };

__device__ __forceinline__ int row_of(int t) { return t < NMETA ? NREAL + t : t - NMETA; }
template <int CTRL> __device__ __forceinline__ float dpp_f(float x) { return __builtin_bit_cast(float, __builtin_amdgcn_mov_dpp(__builtin_bit_cast(int, x), CTRL, 0xf, 0xf, true)); }
__device__ __forceinline__ float row16_sum(float x) { x += dpp_f<0xB1>(x); x += dpp_f<0x4E>(x); x += dpp_f<0x124>(x); x += dpp_f<0x128>(x); return x; }
__device__ __forceinline__ float row16_max(float x) { x = fmaxf(x, dpp_f<0xB1>(x)); x = fmaxf(x, dpp_f<0x4E>(x)); x = fmaxf(x, dpp_f<0x124>(x)); x = fmaxf(x, dpp_f<0x128>(x)); return x; }
__device__ __forceinline__ float xrow16_sum(float x) {
    auto s = __builtin_amdgcn_permlane16_swap(__float_as_uint(x), __float_as_uint(x), false, false); x = __uint_as_float(s[0]) + __uint_as_float(s[1]);
    auto t = __builtin_amdgcn_permlane32_swap(__float_as_uint(x), __float_as_uint(x), false, false); return __uint_as_float(t[0]) + __uint_as_float(t[1]); }
__device__ __forceinline__ float xrow16_max(float x) {
    auto s = __builtin_amdgcn_permlane16_swap(__float_as_uint(x), __float_as_uint(x), false, false); x = fmaxf(__uint_as_float(s[0]), __uint_as_float(s[1]));
    auto t = __builtin_amdgcn_permlane32_swap(__float_as_uint(x), __float_as_uint(x), false, false); return fmaxf(__uint_as_float(t[0]), __uint_as_float(t[1])); }
template <int CTRL, int ROWMASK> __device__ __forceinline__ float dpp_z(float x) { return __builtin_bit_cast(float, __builtin_amdgcn_update_dpp(0, __builtin_bit_cast(int, x), CTRL, ROWMASK, 0xf, true)); }
__device__ __forceinline__ float scan32_incl(float x) { x += dpp_z<0x111, 0xf>(x); x += dpp_z<0x112, 0xf>(x); x += dpp_z<0x114, 0xf>(x); x += dpp_z<0x118, 0xf>(x); x += dpp_z<0x142, 0xa>(x); return x; }
__device__ __forceinline__ float wave_sum(float v) { return xrow16_sum(row16_sum(v)); }
__device__ __forceinline__ float wave_max(float v) { return xrow16_max(row16_max(v)); }
typedef __bf16 bf16x2_t __attribute__((ext_vector_type(2)));
__device__ __forceinline__ unsigned pk2(float lo, float hi) { const f32x2 v = {lo, hi}; const bf16x2_t b = __builtin_convertvector(v, bf16x2_t); return __builtin_bit_cast(unsigned, b); }
__device__ __forceinline__ unsigned f2bf(float f) { return pk2(f, f) & 0xffffu; }
__device__ __forceinline__ float bf2f(unsigned b) { return __uint_as_float(b << 16); }
__device__ __forceinline__ float bflo(unsigned w) { return __uint_as_float(w << 16); }
__device__ __forceinline__ float bfhi(unsigned w) { return __uint_as_float(w & 0xffff0000u); }
__device__ __forceinline__ float sigmoidf_(float x) { return __builtin_amdgcn_rcpf(1.0f + __expf(-x)); }
__device__ __forceinline__ float siluf_(float x) { return x * __builtin_amdgcn_rcpf(1.0f + __expf(-x)); }
__device__ __forceinline__ float gelu_tanh(float x) { const float u = 0.7978845608028654f * (x + 0.044715f * x * x * x); return x * __builtin_amdgcn_rcpf(1.0f + __expf(-2.0f * u)); }

namespace pg8 {
#define PG8_LAS __attribute__((address_space(3)))
constexpr int BM = 256, BK = 64, HALF = 128, HTB = HALF * BK * 2, STAGE_BYTES = 8 * HTB, NXCD = 8, WGM = 4;
__host__ __device__ __forceinline__ int lds_byte(int r, int c) { const int st = (r >> 4) * 2 + (c >> 5), rr = r & 15, cc = c & 31, ob = rr * 64 + cc * 2; return st * 1024 + (ob ^ (((ob >> 9) & 1) << 5)); }
__host__ __device__ __forceinline__ void stage_rc(int b, int& R, int& C) { const int st = b / 1024, sb = b % 1024, swz = sb ^ (((sb >> 9) & 1) << 5); R = (st >> 1) * 16 + swz / 64; C = (st & 1) * 32 + (swz % 64) / 2; }
__host__ __device__ __forceinline__ int perm32(int rho) { const int n = rho >> 4, i = rho & 15; return 8 * (i >> 2) + 4 * n + (i & 3); }
struct Unit { int pm, pn; };
struct Gemm { const bf16_t* A; const bf16_t* Bt; int M, N, K; };
struct StaticOrder {
    int nM, nN, nwg, G, c;
    __host__ __device__ void init(int M, int N, int G_, int c_) { nM = M / BM; nN = N / BM; nwg = nM * nN; G = G_; c = c_; }
    __host__ __device__ bool next(int i, Unit& u) const {
        const long L = (long)i * G + c; if (L >= nwg) return false;
        int wgid = (int)L; { const int q = nwg / NXCD, r = nwg % NXCD, xcd = wgid % NXCD, off = wgid / NXCD; wgid = (xcd < r ? xcd * (q + 1) : r * (q + 1) + (xcd - r) * q) + off; }
        const int nig = WGM * nN, gid = wgid / nig, fm = gid * WGM, gsz = (nM - fm) < WGM ? (nM - fm) : WGM;
        u.pm = fm + ((wgid % nig) % gsz); u.pn = (wgid % nig) / gsz; return true;
    }
    __device__ __forceinline__ void a_ready(const Unit&) const {}
    __device__ __forceinline__ void done(const Unit&) const {}
};
__device__ __forceinline__ unsigned cvt_pk_bf16(float lo, float hi) { return pk2(lo, hi); }

struct EpiBf16 {
    static constexpr bool PERM = true, AFTER_DRAIN = false;
    bf16_t* O; int ldc; const float* rs;
    __device__ __forceinline__ void operator()(const f32x4 (&acc)[2][2][4][2], const Unit& u, int wr, int wc, int fr, int fq) const {
        const int row0 = u.pm * BM + wr * 64 + fr; const int col0 = u.pn * BM + wc * 32 + 8 * fq;
#pragma unroll
        for (int ai = 0; ai < 2; ++ai)
#pragma unroll
            for (int m = 0; m < 4; ++m) { bf16_t* rowp = O + (size_t)(row0 + ai * HALF + m * 16) * ldc + col0; const float sc = rs ? rs[row0 + ai * HALF + m * 16] : 1.0f;
#pragma unroll
                for (int bj = 0; bj < 2; ++bj) { const f32x4 v0 = acc[ai][bj][m][0] * sc, v1 = acc[ai][bj][m][1] * sc;
                    u32x4 w; w.x = cvt_pk_bf16(v0[0], v0[1]); w.y = cvt_pk_bf16(v0[2], v0[3]); w.z = cvt_pk_bf16(v1[0], v1[1]); w.w = cvt_pk_bf16(v1[2], v1[3]);
                    *(u32x4*)(rowp + bj * HALF) = w; } }
    }
};
struct EpiSwiglu {
    static constexpr bool PERM = true, AFTER_DRAIN = false;
    bf16_t* O; int ldc; const float* rs;
    __device__ __forceinline__ void operator()(const f32x4 (&acc)[2][2][4][2], const Unit& u, int wr, int wc, int fr, int fq) const {
        const int row0 = u.pm * BM + wr * 64 + fr; const int col0 = u.pn * HALF + wc * 32 + 8 * fq;
#pragma unroll
        for (int ai = 0; ai < 2; ++ai)
#pragma unroll
            for (int m = 0; m < 4; ++m) { bf16_t* rowp = O + (size_t)(row0 + ai * HALF + m * 16) * ldc + col0; const float sc = rs[row0 + ai * HALF + m * 16];
                float r[8];
#pragma unroll
                for (int n = 0; n < 2; ++n)
#pragma unroll
                    for (int j = 0; j < 4; ++j) { const float a = acc[ai][0][m][n][j] * sc, b = acc[ai][1][m][n][j] * sc; r[n * 4 + j] = a * __builtin_amdgcn_rcpf(1.0f + __expf(-a)) * b; }
                u32x4 w; w.x = cvt_pk_bf16(r[0], r[1]); w.y = cvt_pk_bf16(r[2], r[3]); w.z = cvt_pk_bf16(r[4], r[5]); w.w = cvt_pk_bf16(r[6], r[7]);
                *(u32x4*)rowp = w; }
    }
};
struct EpiF32 {
    static constexpr bool PERM = false, AFTER_DRAIN = false;
    float* C; int ldc;
    __device__ __forceinline__ void operator()(const f32x4 (&acc)[2][2][4][2], const Unit& u, int wr, int wc, int fr, int fq) const {
        const int row0 = u.pm * BM + wr * 64 + fr, col0 = u.pn * BM + wc * 32 + 4 * fq;
#pragma unroll
        for (int ai = 0; ai < 2; ++ai)
#pragma unroll
            for (int m = 0; m < 4; ++m) { float* rowp = C + (size_t)(row0 + ai * HALF + m * 16) * ldc + col0;
#pragma unroll
                for (int bj = 0; bj < 2; ++bj)
#pragma unroll
                    for (int n = 0; n < 2; ++n) *(f32x4*)(rowp + bj * HALF + n * 16) = acc[ai][bj][m][n]; }
    }
};

template <class Epi, class Sched, bool ALIGN_EPI = false, bool SP2 = false>
__device__ __forceinline__ void gemm_phase(PG8_LAS unsigned char* lds, const Gemm g, const Sched& S, const Epi& E) {
    int tid_ = threadIdx.x; asm volatile("" : "+v"(tid_)); const int tid = tid_, wid = __builtin_amdgcn_readfirstlane(tid >> 6), lane = tid & 63, wr = wid >> 2, wc = wid & 3, fr = lane & 15, fq = lane >> 4;
    const int K = g.K, nt = K / BK;
    unsigned voffA[2], voffB[2];
#pragma unroll
    for (int i = 0; i < 2; ++i) { int R, C; stage_rc(tid * 16 + i * 8192, R, C); const int Rb = Epi::PERM ? ((R & ~31) + perm32(R & 31)) : R;
        voffA[i] = (unsigned)(R * K + C) * 2u; voffB[i] = (unsigned)(Rb * K + C) * 2u; }
    const size_t kstep = (size_t)(BK * 2);
    const size_t hstep = (size_t)HALF * K * 2;
    const size_t tstep = 2 * hstep;
    const unsigned ldsw = (unsigned)wid * 1024u;
    const int aoff = lds_byte(wr * 64 + fr, fq * 8), boff = lds_byte(wc * 32 + fr, fq * 8);
#define PG8_SA(b, h) (((b) * 2 + (h)) * HTB)
#define PG8_SB(b, h) ((4 + (b) * 2 + (h)) * HTB)
#define PG8_STAGE(bufoff, gbase, voff) do { _Pragma("unroll") for (int _i = 0; _i < 2; ++_i) \
        __builtin_amdgcn_global_load_lds((const unsigned*)((const char*)(gbase) + (voff)[_i]), (PG8_LAS unsigned*)(lds + (bufoff) + ldsw + _i * 8192), 16, 0, 0); } while (0)
#define PG8_LDA(dst, b, h) do { _Pragma("unroll") for (int m = 0; m < 4; ++m) _Pragma("unroll") for (int k = 0; k < 2; ++k) dst[m][k] = *(const PG8_LAS bf16x8*)(lds + PG8_SA(b, h) + aoff + m * 2048 + k * 1024); } while (0)
#define PG8_LDB(dst, b, h) do { _Pragma("unroll") for (int n = 0; n < 2; ++n) _Pragma("unroll") for (int k = 0; k < 2; ++k) dst[n][k] = *(const PG8_LAS bf16x8*)(lds + PG8_SB(b, h) + boff + n * 2048 + k * 1024); } while (0)
#define PG8_MMA(ai, bj, At, Bt) do { __builtin_amdgcn_s_setprio(1); _Pragma("unroll") for (int m = 0; m < 4; ++m) _Pragma("unroll") for (int n = 0; n < 2; ++n) _Pragma("unroll") for (int k = 0; k < 2; ++k) \
        acc[ai][bj][m][n] = __builtin_amdgcn_mfma_f32_16x16x32_bf16(Bt[n][k], At[m][k], acc[ai][bj][m][n], 0, 0, 0); __builtin_amdgcn_s_setprio(0); } while (0)
#define PG8_WAIT_V(n) asm volatile("s_waitcnt vmcnt(" #n ")" ::: "memory")
#define PG8_WAIT_L(n) asm volatile("s_waitcnt lgkmcnt(" #n ")" ::: "memory")
#define PG8_BAR __builtin_amdgcn_s_barrier()
#define PG8_SCHED __builtin_amdgcn_sched_barrier(0)
    Unit cur, nxt; int ui = 0;
    if (!S.next(0, cur)) return;
    f32x4 acc[2][2][4][2];
#pragma unroll
    for (int a = 0; a < 2; ++a)
#pragma unroll
        for (int b = 0; b < 2; ++b)
#pragma unroll
            for (int m = 0; m < 4; ++m)
#pragma unroll
                for (int n = 0; n < 2; ++n) acc[a][b][m][n] = (f32x4){0.f, 0.f, 0.f, 0.f};
    bf16x8 At[4][2], B0[2][2], B1[2][2];
    const char* cA = (const char*)g.A + (size_t)cur.pm * tstep; const char* cB = (const char*)g.Bt + (size_t)cur.pn * tstep;
    S.a_ready(cur);
    if constexpr (SP2) {
        PG8_STAGE(PG8_SB(0, 0), cB, voffB); PG8_STAGE(PG8_SB(0, 1), cB + hstep, voffB); PG8_STAGE(PG8_SA(0, 0), cA, voffA); PG8_STAGE(PG8_SA(0, 1), cA + hstep, voffA);
        if (wr == 1) PG8_BAR;
        PG8_WAIT_V(2); PG8_BAR;
        PG8_STAGE(PG8_SB(1, 0), cB + kstep, voffB); PG8_STAGE(PG8_SA(1, 0), cA + kstep, voffA); PG8_STAGE(PG8_SB(1, 1), cB + hstep + kstep, voffB);
        PG8_WAIT_V(6); PG8_BAR;
    } else {
        PG8_STAGE(PG8_SB(0, 0), cB, voffB); PG8_STAGE(PG8_SA(0, 0), cA, voffA); PG8_STAGE(PG8_SB(0, 1), cB + hstep, voffB); PG8_STAGE(PG8_SA(0, 1), cA + hstep, voffA);
        if (wr == 1) PG8_BAR;
        PG8_WAIT_V(4); PG8_BAR;
        PG8_STAGE(PG8_SB(1, 0), cB + kstep, voffB); PG8_STAGE(PG8_SA(1, 0), cA + kstep, voffA); PG8_STAGE(PG8_SB(1, 1), cB + hstep + kstep, voffB);
        PG8_WAIT_V(6); PG8_BAR;
    }
    for (;;) {
        const bool has_next = S.next(ui + 1, nxt);
        const char* nA = has_next ? (const char*)g.A + (size_t)nxt.pm * tstep : cA; const char* nB = has_next ? (const char*)g.Bt + (size_t)nxt.pn * tstep : cB;
        for (int t = 0; t < nt; t += 2) {
            const bool last = (t == nt - 2);
            const char* a1 = cA + (size_t)(t + 1) * kstep;
            const char* a2 = last ? nA : cA + (size_t)(t + 2) * kstep; const char* b2 = last ? nB : cB + (size_t)(t + 2) * kstep;
            const char* a3 = a2 + kstep; const char* b3 = b2 + kstep;
            if (last && has_next) S.a_ready(nxt);
            if constexpr (SP2) {
            PG8_LDB(B0, 0, 0); PG8_LDB(B1, 0, 1); PG8_SCHED; PG8_LDA(At, 0, 0); PG8_STAGE(PG8_SA(1, 1), a1 + hstep, voffA);
            PG8_WAIT_V(8); PG8_WAIT_L(0); PG8_BAR; PG8_MMA(0, 0, At, B0); PG8_MMA(0, 1, At, B1); PG8_BAR; PG8_SCHED;
            PG8_LDA(At, 0, 1); PG8_STAGE(PG8_SB(0, 0), b2, voffB); PG8_STAGE(PG8_SB(0, 1), b2 + hstep, voffB); PG8_STAGE(PG8_SA(0, 0), a2, voffA);
            PG8_WAIT_V(8); PG8_WAIT_L(0); PG8_BAR; PG8_MMA(1, 0, At, B0); PG8_MMA(1, 1, At, B1); PG8_BAR; PG8_SCHED;
            PG8_LDB(B0, 1, 0); PG8_LDB(B1, 1, 1); PG8_SCHED; PG8_LDA(At, 1, 0); PG8_STAGE(PG8_SA(0, 1), a2 + hstep, voffA);
            PG8_WAIT_V(8); PG8_WAIT_L(0); PG8_BAR; PG8_MMA(0, 0, At, B0); PG8_MMA(0, 1, At, B1); PG8_BAR; PG8_SCHED;
            PG8_LDA(At, 1, 1); PG8_STAGE(PG8_SB(1, 0), b3, voffB); PG8_STAGE(PG8_SB(1, 1), b3 + hstep, voffB); PG8_STAGE(PG8_SA(1, 0), a3, voffA);
            PG8_WAIT_V(8); PG8_WAIT_L(0); PG8_BAR; PG8_MMA(1, 0, At, B0); PG8_MMA(1, 1, At, B1); PG8_BAR; PG8_SCHED;
            } else {
            PG8_LDB(B0, 0, 0); PG8_SCHED; PG8_LDA(At, 0, 0); PG8_STAGE(PG8_SA(1, 1), a1 + hstep, voffA);
            PG8_WAIT_L(8); PG8_BAR; PG8_WAIT_L(0); PG8_MMA(0, 0, At, B0); PG8_BAR; PG8_SCHED;
            PG8_LDB(B1, 0, 1); PG8_STAGE(PG8_SB(0, 0), b2, voffB);
            PG8_BAR; PG8_WAIT_L(0); PG8_MMA(0, 1, At, B1); PG8_BAR;
            PG8_LDA(At, 0, 1); PG8_STAGE(PG8_SA(0, 0), a2, voffA);
            PG8_BAR; PG8_WAIT_L(0); PG8_MMA(1, 0, At, B0); PG8_BAR; PG8_SCHED;
            PG8_STAGE(PG8_SB(0, 1), b2 + hstep, voffB);
            PG8_WAIT_V(6); PG8_BAR; PG8_MMA(1, 1, At, B1); PG8_BAR;
            PG8_LDB(B0, 1, 0); PG8_SCHED; PG8_LDA(At, 1, 0); PG8_STAGE(PG8_SA(0, 1), a2 + hstep, voffA);
            PG8_WAIT_L(8); PG8_BAR; PG8_WAIT_L(0); PG8_MMA(0, 0, At, B0); PG8_BAR; PG8_SCHED;
            PG8_LDB(B1, 1, 1); PG8_STAGE(PG8_SB(1, 0), b3, voffB);
            PG8_BAR; PG8_WAIT_L(0); PG8_MMA(0, 1, At, B1); PG8_BAR;
            PG8_LDA(At, 1, 1); PG8_STAGE(PG8_SA(1, 0), a3, voffA);
            PG8_BAR; PG8_WAIT_L(0); PG8_MMA(1, 0, At, B0); PG8_BAR; PG8_SCHED;
            PG8_STAGE(PG8_SB(1, 1), b3 + hstep, voffB);
            PG8_WAIT_V(6); PG8_BAR; PG8_MMA(1, 1, At, B1); PG8_BAR;
            }
        }
        if constexpr (ALIGN_EPI) { if (wr == 0) PG8_BAR; }
        if constexpr (!Epi::AFTER_DRAIN) { E(acc, cur, wr, wc, fr, fq); S.done(cur); }
        if (!has_next) break;
#pragma unroll
        for (int a = 0; a < 2; ++a)
#pragma unroll
            for (int b = 0; b < 2; ++b)
#pragma unroll
                for (int m = 0; m < 4; ++m)
#pragma unroll
                    for (int n = 0; n < 2; ++n) acc[a][b][m][n] = (f32x4){0.f, 0.f, 0.f, 0.f};
        cur = nxt; cA = nA; cB = nB; ++ui;
        if constexpr (ALIGN_EPI) { if (wr == 1) PG8_BAR; }
    }
    PG8_WAIT_V(0);
    if constexpr (!ALIGN_EPI) { if (wr == 0) PG8_BAR; }
    PG8_BAR;
    if constexpr (Epi::AFTER_DRAIN) { E.fused(acc, cur, wr, wc, fr, fq, lds, wid, lane); S.done(cur); }
#undef PG8_SA
#undef PG8_SB
#undef PG8_STAGE
#undef PG8_LDA
#undef PG8_LDB
#undef PG8_MMA
#undef PG8_WAIT_V
#undef PG8_WAIT_L
#undef PG8_BAR
#undef PG8_SCHED
}
}

#define XB_TMO      128
#define XB_XCNT(j)  (256  + 64 * (j))
#define XB_XSUB(j)  (1280 + 64 * (j))
#define XB_XGEN(j)  (2304 + 64 * (j))
#define XB_TOP      3328
#define XB_TOPGEN   3392
#define XCD_BAR_WORDS 3456
#define XB_SPIN_CAP (1u << 18)

__device__ __forceinline__ unsigned xb_ld(unsigned* p)              { return __hip_atomic_load(p, __ATOMIC_RELAXED, __HIP_MEMORY_SCOPE_AGENT); }
__device__ __forceinline__ unsigned xb_add(unsigned* p, unsigned v) { return __hip_atomic_fetch_add(p, v, __ATOMIC_RELAXED, __HIP_MEMORY_SCOPE_AGENT); }
__device__ __forceinline__ unsigned xb_xcc_id() { return (unsigned)__builtin_amdgcn_s_getreg((3 << 11) | 20) & 0xFu; }
#define XB_SPIN(cond, bar) do { unsigned _sp = 0; while (cond) { __builtin_amdgcn_s_sleep(1); \
    if ((++_sp & 255u) == 0u) { if (xb_ld(&(bar)[XB_TMO])) break; if (_sp > XB_SPIN_CAP) { atomicAdd(&(bar)[XB_TMO], 1u); break; } } } } while (0)

struct XcdBarrier {
    unsigned* bar; unsigned x;
    volatile LAS unsigned* st;
};

__device__ __forceinline__ XcdBarrier xcd_barrier_post(unsigned* bar, volatile LAS unsigned* st) {
    XcdBarrier b; b.bar = bar; b.x = xb_xcc_id(); b.st = st;
    if (threadIdx.x == 0) (void)xb_add(&bar[XB_XCNT(b.x)], 1u);
    return b;
}
__device__ __forceinline__ void xcd_barrier_complete(unsigned* bar, unsigned x, unsigned& nloc, unsigned& nx) {
    const unsigned G = gridDim.x * gridDim.y * gridDim.z;
    unsigned sum, cnt, mine, sp = 0u;
    for (;;) {
        sum = 0u; cnt = 0u; mine = 0u;
#pragma unroll
        for (unsigned j = 0; j < 16; ++j) { const unsigned c = xb_ld(&bar[XB_XCNT(j)]); sum += c; cnt += (c > 0u) ? 1u : 0u; mine = (j == x) ? c : mine; }
        if (sum == G) break;
        __builtin_amdgcn_s_sleep(1);
        if ((++sp & 255u) == 0u) { if (xb_ld(&bar[XB_TMO])) break; if (sp > XB_SPIN_CAP) { atomicAdd(&bar[XB_TMO], 1u); break; } }
    }
    nloc = mine > 0u ? mine : 1u; nx = cnt > 0u ? cnt : 1u;
}

__device__ __forceinline__ void xcd_barrier(const XcdBarrier& b) {
    asm volatile("s_waitcnt vmcnt(0)" ::: "memory");
    __syncthreads();
    if (threadIdx.x == 0) {
        unsigned* bar = b.bar;
        __builtin_amdgcn_s_waitcnt(0);
        unsigned nloc = b.st[0], nx = b.st[1];
        if (nloc == 0u) { xcd_barrier_complete(bar, b.x, nloc, nx); b.st[0] = nloc; b.st[1] = nx; }
        const unsigned old = xb_add(&bar[XB_XSUB(b.x)], 1u);
        const unsigned gen = old / nloc;
        if (old + 1u == (gen + 1u) * nloc) {
            __builtin_amdgcn_fence(__ATOMIC_RELEASE, "agent");
            asm volatile("s_waitcnt vmcnt(0)" ::: "memory");
            const unsigned og = xb_add(&bar[XB_TOP], 1u);
            const unsigned tg = og / nx;
            if (og + 1u == (tg + 1u) * nx) xb_add(&bar[XB_TOPGEN], 1u);
            else XB_SPIN(xb_ld(&bar[XB_TOPGEN]) == tg, bar);
            __builtin_amdgcn_fence(__ATOMIC_ACQUIRE, "agent");
            xb_add(&bar[XB_XGEN(b.x)], 1u);
            asm volatile("s_waitcnt vmcnt(0)" ::: "memory");
        } else {
            XB_SPIN(xb_ld(&bar[XB_XGEN(b.x)]) == gen, bar);
            __builtin_amdgcn_fence(__ATOMIC_ACQUIRE, "agent");
            asm volatile("s_waitcnt vmcnt(0)" ::: "memory");
        }
    }
    __syncthreads();
}

struct Ctx { LAS unsigned char* lds; unsigned char* ws; int tid, lane, wave, G, b; };
#define LDS_WAIT() asm volatile("s_waitcnt lgkmcnt(0)" ::: "memory")

__device__ __forceinline__ void transpose_item(const float* W, int K, int N, bf16_t* WT, int dst_row0, LAS float* scr, int k0, int n0, int lane, const float* gk = nullptr) {
    float tv[32];
#pragma unroll
    for (int i = 0; i < 32; ++i) { const int kk = 2 * i + (lane >> 5); tv[i] = (n0 + (lane & 31)) < N ? __builtin_nontemporal_load(W + (size_t)(k0 + kk) * N + n0 + (lane & 31)) : 0.f; }
#pragma unroll
    for (int i = 0; i < 32; ++i) { const int kk = 2 * i + (lane >> 5); scr[kk * 33 + (lane & 31)] = tv[i]; }
    LDS_WAIT();
    const int c = lane & 7;
    f32x4 ga = (f32x4){1.f, 1.f, 1.f, 1.f}, gb = ga; if (gk) { ga = *(const f32x4*)(gk + k0 + 8 * c); gb = *(const f32x4*)(gk + k0 + 8 * c + 4); }
#pragma unroll
    for (int j = 0; j < 4; ++j) { const int n = (lane >> 3) + 8 * j; const LAS float* s = scr + (8 * c) * 33 + n;
        u32x4 o; o.x = pk2(s[0 * 33] * ga[0], s[1 * 33] * ga[1]); o.y = pk2(s[2 * 33] * ga[2], s[3 * 33] * ga[3]); o.z = pk2(s[4 * 33] * gb[0], s[5 * 33] * gb[1]); o.w = pk2(s[6 * 33] * gb[2], s[7 * 33] * gb[3]);
        *(u32x4*)(WT + (size_t)(dst_row0 + n) * K + k0 + 8 * c) = o; }
    LDS_WAIT();
}
__device__ __forceinline__ int conv_hidden_13(int layer) { return layer == 0 ? 11264 : 11264; }
__device__ __forceinline__ void phase_convert(const Params& p, const Ctx& c, int layer, int part, int gw, int NGW) {
    LAS float* scr = (LAS float*)(c.lds) + c.wave * (64 * 33);
    const float* Win = layer == 0 ? p.in[I_AB_IN] : p.in[I_CD_IN]; const int Nin = layer == 0 ? N_AB : N_CD;
    const float* Wout = layer == 0 ? p.in[I_AB_OUT] : p.in[I_CD_OUT];
    const float* W1 = p.in[I_W1] + (size_t)layer * DM * DFF; const float* W3 = p.in[I_W3] + (size_t)layer * DM * DFF; const float* W2 = p.in[I_W2] + (size_t)layer * DFF * DM;
    bf16_t* Tin = (bf16_t*)(c.ws + WS_W + W_IN); bf16_t* Tout = (bf16_t*)(c.ws + WS_W + W_OUT); bf16_t* T13 = (bf16_t*)(c.ws + WS_W + W_13); bf16_t* T2 = (bf16_t*)(c.ws + WS_W + W_2);
    const int i_in = (DM / 64) * ((Nin + 31) / 32), i_out = (DM / 64) * (DM / 32), i_13 = (DM / 64) * (DFF / 32), i_2 = (DFF / 64) * (DM / 32);
    const int total = i_in + i_out + 2 * i_13 + i_2, cut1 = layer == 0 ? i_in : i_in + i_out + 2 * i_13 - conv_hidden_13(layer), cut2 = i_in + i_out + 2 * i_13;
    int lo = part == 0 ? 0 : part == 1 ? cut1 : cut2, hi = part == 0 ? cut1 : part == 1 ? cut2 : total;
    if (part == 3) { lo = i_in; hi = i_in + i_out; }
    if (layer == 1 && part == 0) hi = i_in;
    for (int it = lo + gw; it < hi; it += NGW) {
        int r = it;
        if (r < i_in) { const int nb = (Nin + 31) / 32, kb = r / nb, n0 = 32 * (r % nb); transpose_item(Win, DM, Nin, Tin, n0, scr, 64 * kb, n0, c.lane, p.in[I_LN_MIX_PRE] + layer * DM); continue; } r -= i_in;
        if (r < i_out) { const int nb = DM / 32, kb = r / nb, n0 = 32 * (r % nb); transpose_item(Wout, DM, DM, Tout, n0, scr, 64 * kb, n0, c.lane); continue; } r -= i_out;
        if (r < i_13) { const int nb = DFF / 32, kb = r / nb, n0 = 32 * (r % nb); transpose_item(W1, DM, DFF, T13, (n0 >> 7) * 256 + (n0 & 127), scr, 64 * kb, n0, c.lane, p.in[I_LN_FFN_PRE] + layer * DM); continue; } r -= i_13;
        if (r < i_13) { const int nb = DFF / 32, kb = r / nb, n0 = 32 * (r % nb); transpose_item(W3, DM, DFF, T13, (n0 >> 7) * 256 + 128 + (n0 & 127), scr, 64 * kb, n0, c.lane, p.in[I_LN_FFN_PRE] + layer * DM); continue; } r -= i_13;
        { const int nb = DM / 32, kb = r / nb, n0 = 32 * (r % nb); transpose_item(W2, DFF, DM, T2, n0, scr, 64 * kb, n0, c.lane); }
    }
    if (layer == 1 && part == 0) {
        u32x4* z = (u32x4*)(Tin + (size_t)4448 * DM); const int n16 = (N_CDP - 4448) * DM * 2 / 16;
        for (int i = c.b * NTHR + c.tid; i < n16; i += c.G * NTHR) z[i] = (u32x4){0u, 0u, 0u, 0u};
    }
}

__device__ __forceinline__ void phase_norm0(const Params& p, const Ctx& c) {
    bf16_t* H = (bf16_t*)(c.ws + WS_H); bf16_t* HN = (bf16_t*)(c.ws + WS_HN); const float* g = p.in[I_LN_MIX_PRE];
    for (int r = c.b * NWAVES + c.wave; r < NTOK; r += c.G * NWAVES) {
        u32x2* hrow = (u32x2*)(H + (size_t)r * DM); u32x2* nrow = (u32x2*)(HN + (size_t)r * DM);
        const f32x4* src = (const f32x4*)(r < NREAL ? p.in[I_X] + (size_t)r * DM : p.in[I_META] + (size_t)(r - NREAL) * DM);
        f32x4 v[8]; float ss = 0.f;
#pragma unroll
        for (int j = 0; j < 8; ++j) { v[j] = __builtin_nontemporal_load(src + c.lane + 64 * j); ss += v[j][0] * v[j][0] + v[j][1] * v[j][1] + v[j][2] * v[j][2] + v[j][3] * v[j][3]; }
        const float rstd = 1.0f / sqrtf(wave_sum(ss) * (1.0f / DM) + EPS);
#pragma unroll
        for (int j = 0; j < 8; ++j) hrow[c.lane + 64 * j] = (u32x2){pk2(v[j][0], v[j][1]), pk2(v[j][2], v[j][3])};
        if (c.lane == 0) ((float*)(c.ws + WS_RS))[r] = rstd;
    }
}
__device__ __forceinline__ void phase_normres(const Params& p, const Ctx& c, const float* gpost, const float* gnext, bool final_) {
    bf16_t* H = (bf16_t*)(c.ws + WS_H); bf16_t* HN = (bf16_t*)(c.ws + WS_HN); const bf16_t* Y = (const bf16_t*)(c.ws + WS_BIG + B_Y);
    const int nrows = final_ ? NREAL : NTOK;
    for (int r = c.b * NWAVES + c.wave; r < nrows; r += c.G * NWAVES) {
        u32x4* hrow = (u32x4*)(H + (size_t)r * DM); const u32x4* yrow = (const u32x4*)(Y + (size_t)r * DM);
        u32x4 yr[4], hr[4];
#pragma unroll
        for (int j = 0; j < 4; ++j) { yr[j] = __builtin_nontemporal_load(yrow + c.lane + 64 * j); hr[j] = hrow[c.lane + 64 * j]; }
        float y[4][8]; float ss = 0.f;
#pragma unroll
        for (int j = 0; j < 4; ++j) { const unsigned wv[4] = {yr[j].x, yr[j].y, yr[j].z, yr[j].w};
#pragma unroll
            for (int i = 0; i < 4; ++i) { y[j][2 * i] = bflo(wv[i]); y[j][2 * i + 1] = bfhi(wv[i]); ss += y[j][2 * i] * y[j][2 * i] + y[j][2 * i + 1] * y[j][2 * i + 1]; } }
        const float rstd = 1.0f / sqrtf(wave_sum(ss) * (1.0f / DM) + EPS);
        float s2 = 0.f;
#pragma unroll
        for (int j = 0; j < 4; ++j) { const int col = (c.lane + 64 * j) * 8; const f32x4 g0 = *(const f32x4*)(gpost + col), g1 = *(const f32x4*)(gpost + col + 4); const unsigned hv[4] = {hr[j].x, hr[j].y, hr[j].z, hr[j].w};
#pragma unroll
            for (int i = 0; i < 4; ++i) { const float ga = i < 2 ? g0[2 * i] : g1[2 * i - 4], gb = i < 2 ? g0[2 * i + 1] : g1[2 * i - 3];
                y[j][2 * i] = bflo(hv[i]) + y[j][2 * i] * rstd * ga; y[j][2 * i + 1] = bfhi(hv[i]) + y[j][2 * i + 1] * rstd * gb; s2 += y[j][2 * i] * y[j][2 * i] + y[j][2 * i + 1] * y[j][2 * i + 1]; } }
        if (final_) {
            float* orow = p.out + (size_t)r * DM;
#pragma unroll
            for (int j = 0; j < 4; ++j) { const int col = (c.lane + 64 * j) * 8; __builtin_nontemporal_store((f32x4){y[j][0], y[j][1], y[j][2], y[j][3]}, (f32x4*)(orow + col)); __builtin_nontemporal_store((f32x4){y[j][4], y[j][5], y[j][6], y[j][7]}, (f32x4*)(orow + col + 4)); }
        } else {
            u32x4 hb[4]; float s2b = 0.f;
#pragma unroll
            for (int j = 0; j < 4; ++j) { hb[j] = (u32x4){pk2(y[j][0], y[j][1]), pk2(y[j][2], y[j][3]), pk2(y[j][4], y[j][5]), pk2(y[j][6], y[j][7])}; const unsigned hw[4] = {hb[j].x, hb[j].y, hb[j].z, hb[j].w};
#pragma unroll
                for (int i = 0; i < 4; ++i) s2b += bflo(hw[i]) * bflo(hw[i]) + bfhi(hw[i]) * bfhi(hw[i]); hrow[c.lane + 64 * j] = hb[j]; }
            const float rstd2 = 1.0f / sqrtf(wave_sum(s2b) * (1.0f / DM) + EPS);
            if (c.lane == 0) ((float*)(c.ws + WS_RS))[r] = rstd2;
        }
    }
}

__device__ __forceinline__ void hgrn_scan_simple(const Params& p, const Ctx& c, int hd) {
    const bf16_t* proj = (const bf16_t*)(c.ws + WS_BIG + B_PROJ); float* HO = (float*)(c.ws + WS_BIG + B_HO);
    LAS float* sf = (LAS float*)c.lds; LAS float* sk = sf + 2048; LAS float* sq = sk + 2048; LAS float* sv = sq + 2048;
    const int v = c.tid >> 2, kq = c.tid & 3, lt = c.tid >> 5, lc = (c.tid & 31) * 4;
    float lbv[4];
#pragma unroll
    for (int i = 0; i < 4; ++i) { const int ch = hd * 128 + lc + i; const float l0 = p.in[I_LB][ch], l1 = p.in[I_LB][1024 + ch]; lbv[i] = 1.0f / (1.0f + __expf(l1 - l0)); }
    float S[32];
#pragma unroll
    for (int i = 0; i < 32; ++i) S[i] = 0.f;
    for (int t0 = 0; t0 < NTOK; t0 += 16) {
        __syncthreads();
        { const int row = row_of(t0 + lt); const bf16_t* pr = proj + (size_t)row * N_AB + hd * 128 + lc;
          const u32x2 qv = *(const u32x2*)pr, fv = *(const u32x2*)(pr + 1024), vv = *(const u32x2*)(pr + 2048);
          const float q4[4] = {bflo(qv.x), bfhi(qv.x), bflo(qv.y), bfhi(qv.y)}, f4[4] = {bflo(fv.x), bfhi(fv.x), bflo(fv.y), bfhi(fv.y)}, v4[4] = {bflo(vv.x), bfhi(vv.x), bflo(vv.y), bfhi(vv.y)};
#pragma unroll
          for (int i = 0; i < 4; ++i) { const float f = lbv[i] + (1.0f - lbv[i]) * sigmoidf_(f4[i]); const int o = lt * 128 + lc + i; sf[o] = f; sk[o] = 1.0f - f; sq[o] = q4[i]; sv[o] = v4[i]; } }
        __syncthreads();
        for (int tt = 0; tt < 16; ++tt) {
            const float vv = sv[tt * 128 + v]; float o = 0.f;
            const LAS f32x4* f4p = (const LAS f32x4*)(sf + tt * 128 + kq * 32); const LAS f32x4* k4p = (const LAS f32x4*)(sk + tt * 128 + kq * 32); const LAS f32x4* q4p = (const LAS f32x4*)(sq + tt * 128 + kq * 32);
#pragma unroll
            for (int i4 = 0; i4 < 8; ++i4) { const f32x4 ff = f4p[i4], kk = k4p[i4], qq = q4p[i4];
#pragma unroll
                for (int j = 0; j < 4; ++j) { S[i4 * 4 + j] = ff[j] * S[i4 * 4 + j] + kk[j] * vv; o += qq[j] * S[i4 * 4 + j]; } }
            o += __shfl_xor(o, 1); o += __shfl_xor(o, 2);
            if (kq == 0) HO[(size_t)row_of(t0 + tt) * 1024 + hd * 128 + v] = o;
        }
    }
}
constexpr int HG_NSC = 33;
constexpr size_t B_HL = B_Y;
constexpr size_t B_HD = B_HL + (size_t)HG_NSC * 8 * 16384 * 4;
template <bool OUT>
__device__ __forceinline__ void hgrn_item(const Params& p, const Ctx& c, int hd, int sc) {
    const bf16_t* proj = (const bf16_t*)(c.ws + WS_BIG + B_PROJ); float* HL = (float*)(c.ws + WS_BIG + B_HL); float* HD = (float*)(c.ws + WS_BIG + B_HD); bf16_t* MO = (bf16_t*)(c.ws + WS_HN);
    LAS bf16_t* Qs = (LAS bf16_t*)c.lds; LAS bf16_t* Ks = Qs + 32 * 136; LAS bf16_t* KeT = Ks + 32 * 136; LAS bf16_t* VT = KeT + 128 * 40; LAS bf16_t* ST = VT + 128 * 40;
    LAS float* dec = (LAS float*)(ST + 128 * 136); LAS bf16_t* Pw = (LAS bf16_t*)(dec + 128) + c.wave * (32 * 40); LAS float* Ot = (LAS float*)((LAS bf16_t*)(dec + 128) + 8 * 32 * 40);
    const int w = c.wave, l = c.lane, n = l & 15, g = l >> 4, j = l & 31, d0 = 8 * (2 * w + (l >> 5));
    float lb[8], omlb[8];
#pragma unroll
    for (int i = 0; i < 8; ++i) { const int ch = hd * 128 + d0 + i; lb[i] = 1.0f / (1.0f + __expf(p.in[I_LB][1024 + ch] - p.in[I_LB][ch])); omlb[i] = 1.0f - lb[i]; }
    const int nss = sc == 0 ? 1 : 8;
    const size_t sbase = (size_t)(sc * 8 + hd) * 16384;
    f32x4 acc[8];
#pragma unroll
    for (int kt = 0; kt < 8; ++kt) {
        if (OUT) {
#pragma unroll
            for (int r = 0; r < 4; ++r) { const float s = HL[sbase + (size_t)(16 * w + 4 * g + r) * 128 + 16 * kt + n]; acc[kt][r] = s; ST[(16 * w + 4 * g + r) * 136 + 16 * kt + n] = (bf16_t)f2bf(s); }
        } else acc[kt] = (f32x4){0.f, 0.f, 0.f, 0.f};
    }
    float btot[8];
#pragma unroll
    for (int i = 0; i < 8; ++i) btot[i] = 0.f;
    u32x4 rq, rf, rv;
    { const int row = sc == 0 ? NREAL + (j & 15) : (sc - 1) * 256 + j; const bf16_t* pr = proj + (size_t)row * N_AB + hd * 128 + d0; rq = *(const u32x4*)pr; rf = *(const u32x4*)(pr + 1024); rv = *(const u32x4*)(pr + 2048); }
    for (int ss = 0; ss < nss; ++ss) {
        if (sc == 0 && j >= 16) { rq = (u32x4){0u, 0u, 0u, 0u}; rv = rq; rf = (u32x4){0x43004300u, 0x43004300u, 0x43004300u, 0x43004300u}; }
        float q[8] = {bflo(rq.x), bfhi(rq.x), bflo(rq.y), bfhi(rq.y), bflo(rq.z), bfhi(rq.z), bflo(rq.w), bfhi(rq.w)};
        float fl[8] = {bflo(rf.x), bfhi(rf.x), bflo(rf.y), bfhi(rf.y), bflo(rf.z), bfhi(rf.z), bflo(rf.w), bfhi(rf.w)};
        const u32x4 rv0 = rv;
        if (ss + 1 < nss) { const int row = (sc - 1) * 256 + (ss + 1) * 32 + j; const bf16_t* pr = proj + (size_t)row * N_AB + hd * 128 + d0; rq = *(const u32x4*)pr; rf = *(const u32x4*)(pr + 1024); rv = *(const u32x4*)(pr + 2048); }
        float k[8], b[8];
#pragma unroll
        for (int i = 0; i < 8; ++i) { const float f = lb[i] + omlb[i] * sigmoidf_(fl[i]); k[i] = 1.0f - f; b[i] = 0.6931471805599453f * __builtin_amdgcn_logf(f); }
#pragma unroll
        for (int i = 0; i < 8; ++i) b[i] = scan32_incl(b[i]);
        float qs[8], ks[8], ke[8], b31v[8];
#pragma unroll
        for (int i = 0; i < 8; ++i) { const float b31 = __shfl(b[i], 31, 32);
            qs[i] = q[i] * __expf(b[i]); ks[i] = k[i] * __expf(fminf(-b[i], 80.f)); ke[i] = k[i] * __expf(b31 - b[i]);
            b31v[i] = b31; btot[i] += b31; }
        { const unsigned rvw[4] = {rv0.x, rv0.y, rv0.z, rv0.w};
#pragma unroll
          for (int i = 0; i < 8; i += 2) { const unsigned kw = pk2(ke[i], ke[i + 1]);
            KeT[(d0 + i) * 40 + j] = (bf16_t)(kw & 0xffffu); KeT[(d0 + i + 1) * 40 + j] = (bf16_t)(kw >> 16);
            VT[(d0 + i) * 40 + j] = (bf16_t)(rvw[i >> 1] & 0xffffu); VT[(d0 + i + 1) * 40 + j] = (bf16_t)(rvw[i >> 1] >> 16); } }
        if (j == 31) { *(LAS f32x4*)(dec + d0) = (f32x4){__expf(b31v[0]), __expf(b31v[1]), __expf(b31v[2]), __expf(b31v[3])}; *(LAS f32x4*)(dec + d0 + 4) = (f32x4){__expf(b31v[4]), __expf(b31v[5]), __expf(b31v[6]), __expf(b31v[7])}; }
        if (OUT) { *(LAS u32x4*)(Qs + j * 136 + d0) = (u32x4){pk2(qs[0], qs[1]), pk2(qs[2], qs[3]), pk2(qs[4], qs[5]), pk2(qs[6], qs[7])};
                   *(LAS u32x4*)(Ks + j * 136 + d0) = (u32x4){pk2(ks[0], ks[1]), pk2(ks[2], ks[3]), pk2(ks[4], ks[5]), pk2(ks[6], ks[7])}; }
        u32x4 gtp = (u32x4){0u, 0u, 0u, 0u};
        if (OUT) { const int tt_ = c.tid >> 4, v0_ = (c.tid & 15) * 8; const int row_ = sc == 0 ? NREAL + (tt_ & 15) : (sc - 1) * 256 + ss * 32 + tt_; gtp = *(const u32x4*)(proj + (size_t)row_ * N_AB + 3072 + hd * 128 + v0_); }
        __syncthreads();
        const bf16x8 vt = *(const LAS bf16x8*)(VT + (16 * w + n) * 40 + 8 * g);
        if (OUT) {
            bf16x8 aq[2][4];
#pragma unroll
            for (int mt = 0; mt < 2; ++mt)
#pragma unroll
                for (int s = 0; s < 4; ++s) aq[mt][s] = *(const LAS bf16x8*)(Qs + (16 * mt + n) * 136 + 32 * s + 8 * g);
            f32x4 o[2] = {(f32x4){0.f, 0.f, 0.f, 0.f}, (f32x4){0.f, 0.f, 0.f, 0.f}};
#pragma unroll
            for (int s = 0; s < 4; ++s) { const bf16x8 bs = *(const LAS bf16x8*)(ST + (16 * w + n) * 136 + 32 * s + 8 * g);
                o[0] = __builtin_amdgcn_mfma_f32_16x16x32_bf16(aq[0][s], bs, o[0], 0, 0, 0); o[1] = __builtin_amdgcn_mfma_f32_16x16x32_bf16(aq[1][s], bs, o[1], 0, 0, 0); }
            f32x4 pp[2][2];
#pragma unroll
            for (int mt = 0; mt < 2; ++mt)
#pragma unroll
                for (int nt = 0; nt < 2; ++nt) pp[mt][nt] = (f32x4){0.f, 0.f, 0.f, 0.f};
#pragma unroll
            for (int nt = 0; nt < 2; ++nt)
#pragma unroll
                for (int s = 0; s < 4; ++s) { const bf16x8 bk = *(const LAS bf16x8*)(Ks + (16 * nt + n) * 136 + 32 * s + 8 * g);
                    pp[0][nt] = __builtin_amdgcn_mfma_f32_16x16x32_bf16(aq[0][s], bk, pp[0][nt], 0, 0, 0); pp[1][nt] = __builtin_amdgcn_mfma_f32_16x16x32_bf16(aq[1][s], bk, pp[1][nt], 0, 0, 0); }
#pragma unroll
            for (int mt = 0; mt < 2; ++mt)
#pragma unroll
                for (int nt = 0; nt < 2; ++nt)
#pragma unroll
                    for (int r = 0; r < 4; r += 2) { const int ii = 16 * mt + 4 * g + r, jj = 16 * nt + n; const unsigned pw_ = pk2(jj <= ii ? pp[mt][nt][r] : 0.f, jj <= ii + 1 ? pp[mt][nt][r + 1] : 0.f);
                        Pw[ii * 40 + jj] = (bf16_t)(pw_ & 0xffffu); Pw[(ii + 1) * 40 + jj] = (bf16_t)(pw_ >> 16); }
            LDS_WAIT();
#pragma unroll
            for (int mt = 0; mt < 2; ++mt) { const bf16x8 pa = *(const LAS bf16x8*)(Pw + (16 * mt + n) * 40 + 8 * g); o[mt] = __builtin_amdgcn_mfma_f32_16x16x32_bf16(pa, vt, o[mt], 0, 0, 0); }
#pragma unroll
            for (int mt = 0; mt < 2; ++mt)
#pragma unroll
                for (int r = 0; r < 4; ++r) Ot[(16 * mt + 4 * g + r) * 132 + 16 * w + n] = o[mt][r];
        }
#pragma unroll
        for (int kt = 0; kt < 8; ++kt) { const float dk = dec[16 * kt + n]; const bf16x8 bke = *(const LAS bf16x8*)(KeT + (16 * kt + n) * 40 + 8 * g);
            acc[kt] = acc[kt] * dk; acc[kt] = __builtin_amdgcn_mfma_f32_16x16x32_bf16(vt, bke, acc[kt], 0, 0, 0); }
        if (OUT && ss + 1 < nss) {
#pragma unroll
            for (int kt = 0; kt < 8; ++kt)
#pragma unroll
                for (int r = 0; r < 4; r += 2) { const unsigned pw_ = pk2(acc[kt][r], acc[kt][r + 1]); ST[(16 * w + 4 * g + r) * 136 + 16 * kt + n] = (bf16_t)(pw_ & 0xffffu); ST[(16 * w + 4 * g + r + 1) * 136 + 16 * kt + n] = (bf16_t)(pw_ >> 16); }
        }
        __syncthreads();
        if (OUT) {
            const int tt = c.tid >> 4, v0 = (c.tid & 15) * 8;
            const f32x4 x0 = *(const LAS f32x4*)(Ot + tt * 132 + v0), x1 = *(const LAS f32x4*)(Ot + tt * 132 + v0 + 4);
            float ssq = x0[0] * x0[0] + x0[1] * x0[1] + x0[2] * x0[2] + x0[3] * x0[3] + x1[0] * x1[0] + x1[1] * x1[1] + x1[2] * x1[2] + x1[3] * x1[3];
            ssq = row16_sum(ssq);
            const float rstd = __builtin_amdgcn_rsqf(ssq * (1.0f / 128.0f) + EPS);
            if (sc != 0 || tt < 16) {
                const int row = sc == 0 ? NREAL + tt : (sc - 1) * 256 + ss * 32 + tt;
                const u32x4 gt = gtp; const f32x4 g0 = *(const f32x4*)(p.in[I_HG_NORM] + v0), g1 = *(const f32x4*)(p.in[I_HG_NORM] + v0 + 4);
                u32x4 ov; ov.x = pk2(x0[0] * rstd * g0[0] * siluf_(bflo(gt.x)), x0[1] * rstd * g0[1] * siluf_(bfhi(gt.x))); ov.y = pk2(x0[2] * rstd * g0[2] * siluf_(bflo(gt.y)), x0[3] * rstd * g0[3] * siluf_(bfhi(gt.y)));
                ov.z = pk2(x1[0] * rstd * g1[0] * siluf_(bflo(gt.z)), x1[1] * rstd * g1[1] * siluf_(bfhi(gt.z))); ov.w = pk2(x1[2] * rstd * g1[2] * siluf_(bflo(gt.w)), x1[3] * rstd * g1[3] * siluf_(bfhi(gt.w)));
                *(u32x4*)(MO + (size_t)row * DM + hd * 128 + v0) = ov;
            }
        }
    }
    if (!OUT) {
#pragma unroll
        for (int kt = 0; kt < 8; ++kt)
#pragma unroll
            for (int r = 0; r < 4; ++r) HL[sbase + (size_t)(16 * w + 4 * g + r) * 128 + 16 * kt + n] = acc[kt][r];
        if (j == 31) {
#pragma unroll
            for (int i = 0; i < 8; ++i) HD[(size_t)(sc * 8 + hd) * 128 + d0 + i] = __expf(btot[i]); }
    }
    __syncthreads();
}
template <bool OUT>
__device__ __forceinline__ void phase_hgrn(const Params& p, const Ctx& c) {
    for (int it = c.b; it < HG_NSC * 8; it += c.G) { const int hd = it & 7, sc = it < 256 ? 1 + (it >> 3) : 0; hgrn_item<OUT>(p, c, hd, sc); }
}
__device__ __forceinline__ void phase_hgrn_scan(const Params& p, const Ctx& c) {
    float* HL = (float*)(c.ws + WS_BIG + B_HL); const float* HD = (const float*)(c.ws + WS_BIG + B_HD);
    for (int gid = c.b * NTHR + c.tid; gid < 8 * 16384; gid += c.G * NTHR) {
        const int hd = gid >> 14, rem = gid & 16383, kd = rem & 127; float S = 0.f;
        for (int s0 = 0; s0 < HG_NSC; s0 += 11) { float lv[11], dv[11];
#pragma unroll
            for (int k = 0; k < 11; ++k) { lv[k] = HL[(size_t)((s0 + k) * 8 + hd) * 16384 + rem]; dv[k] = HD[(size_t)((s0 + k) * 8 + hd) * 128 + kd]; }
#pragma unroll
            for (int k = 0; k < 11; ++k) { HL[(size_t)((s0 + k) * 8 + hd) * 16384 + rem] = S; S = dv[k] * S + lv[k]; } }
    }
}

__device__ __forceinline__ void sconv_part(const Params& p, const Ctx& c, int b0, int nb) {
    const bf16_t* proj = (const bf16_t*)(c.ws + WS_BIG + B_PROJ); bf16_t* MO = (bf16_t*)(c.ws + WS_HN); const float* w = p.in[I_SCONV];
    const int stride = nb * NTHR, total = NTOK * 256;
    for (int idx0 = (c.b - b0) * NTHR + c.tid; idx0 < total; idx0 += 4 * stride) {
        u32x2 sx[4][3], sc[4][3], sb[4];
#pragma unroll
        for (int u = 0; u < 4; ++u) { const int idx = min(idx0 + u * stride, total - 1), t = idx >> 8, c4 = (idx & 255) * 4;
#pragma unroll
            for (int j = 0; j < 3; ++j) { const int tp = max(t - 2 + j, 0); const bf16_t* pr = proj + (size_t)row_of(tp) * N_AB; sx[u][j] = *(const u32x2*)(pr + 4096 + c4); sc[u][j] = *(const u32x2*)(pr + 6144 + c4); }
            sb[u] = *(const u32x2*)(proj + (size_t)row_of(t) * N_AB + 5120 + c4); }
#pragma unroll
        for (int u = 0; u < 4; ++u) { const int idx = idx0 + u * stride; if (idx >= total) break; const int t = idx >> 8, c4 = (idx & 255) * 4; float acc[4] = {0.f, 0.f, 0.f, 0.f};
#pragma unroll
            for (int j = 0; j < 3; ++j) { if (t - 2 + j < 0) continue; const f32x4 wv = *(const f32x4*)(w + j * 1024 + c4);
                acc[0] += wv[0] * bflo(sx[u][j].x) * bflo(sc[u][j].x); acc[1] += wv[1] * bfhi(sx[u][j].x) * bfhi(sc[u][j].x); acc[2] += wv[2] * bflo(sx[u][j].y) * bflo(sc[u][j].y); acc[3] += wv[3] * bfhi(sx[u][j].y) * bfhi(sc[u][j].y); }
            *(u32x2*)(MO + (size_t)row_of(t) * DM + 1024 + c4) = (u32x2){pk2(acc[0] * bflo(sb[u].x), acc[1] * bfhi(sb[u].x)), pk2(acc[2] * bflo(sb[u].y), acc[3] * bfhi(sb[u].y))}; }
    }
}
__device__ __forceinline__ void phase_hgrn_out(const Params& p, const Ctx& c) {
    const bf16_t* proj = (const bf16_t*)(c.ws + WS_BIG + B_PROJ); const float* HO = (const float*)(c.ws + WS_BIG + B_HO); bf16_t* MO = (bf16_t*)(c.ws + WS_HN); const float* g = p.in[I_HG_NORM];
    for (int it = c.b * NWAVES + c.wave; it < NTOK * 8; it += c.G * NWAVES) {
        const int row = it >> 3, hd = it & 7, ch = hd * 128 + 2 * c.lane;
        const f32x2 o = *(const f32x2*)(HO + (size_t)row * 1024 + ch);
        const float rstd = 1.0f / sqrtf(wave_sum(o[0] * o[0] + o[1] * o[1]) * (1.0f / 128.0f) + EPS);
        const unsigned gt = *(const unsigned*)(proj + (size_t)row * N_AB + 3072 + ch);
        *(unsigned*)(MO + (size_t)row * DM + ch) = pk2(o[0] * rstd * g[2 * c.lane] * siluf_(bflo(gt)), o[1] * rstd * g[2 * c.lane + 1] * siluf_(bfhi(gt)));
    }
}

__device__ __forceinline__ void rg_u_part(const Params& p, const Ctx& c) {
    const bf16_t* proj = (const bf16_t*)(c.ws + WS_BIG + B_PROJ); float* U = (float*)(c.ws + WS_BIG + B_U); const float* w = p.in[I_RG_CW]; const float* bb = p.in[I_RG_CB];
    for (int idx = c.b * NTHR + c.tid; idx < NTOK * 256; idx += c.G * NTHR) {
        const int t = idx >> 8, c4 = (idx & 255) * 4; f32x4 acc = *(const f32x4*)(bb + c4);
#pragma unroll
        for (int j = 0; j < 4; ++j) { const int tp = t - 3 + j; if (tp < 0) continue; const u32x2 rx = *(const u32x2*)(proj + (size_t)row_of(tp) * N_CDP + c4); const f32x4 wv = *(const f32x4*)(w + j * 1024 + c4);
            acc[0] += wv[0] * bflo(rx.x); acc[1] += wv[1] * bfhi(rx.x); acc[2] += wv[2] * bflo(rx.y); acc[3] += wv[3] * bfhi(rx.y); }
        *(f32x4*)(U + (size_t)row_of(t) * 1024 + c4) = acc;
    }
}
__device__ __forceinline__ void dsa_c_part(const Params& p, const Ctx& c) {
    const bf16_t* proj = (const bf16_t*)(c.ws + WS_BIG + B_PROJ); bf16_t* C = (bf16_t*)(c.ws + WS_C); const float* g = p.in[I_KVN];
    for (int r = c.b * NWAVES + c.wave; r < NTOK; r += c.G * NWAVES) {
        const u32x2 v = *(const u32x2*)(proj + (size_t)r * N_CDP + 3072 + 4 * c.lane); const float a0 = bflo(v.x), a1 = bfhi(v.x), a2 = bflo(v.y), a3 = bfhi(v.y);
        const float rstd = 1.0f / sqrtf(wave_sum(a0 * a0 + a1 * a1 + a2 * a2 + a3 * a3) * (1.0f / 256.0f) + EPS); const f32x4 gg = *(const f32x4*)(g + 4 * c.lane);
        *(u32x2*)(C + (size_t)r * 256 + 4 * c.lane) = (u32x2){pk2(a0 * rstd * gg[0], a1 * rstd * gg[1]), pk2(a2 * rstd * gg[2], a3 * rstd * gg[3])};
    }
}
__device__ __forceinline__ void phase_rg_gates(const Params& p, const Ctx& c) {
    const float* U = (const float*)(c.ws + WS_BIG + B_U); float* A = (float*)(c.ws + WS_BIG + B_A); float* X = (float*)(c.ws + WS_BIG + B_X);
    LAS float* su = (LAS float*)c.lds;
    const int sub = c.tid >> 7, d = c.tid & 127; constexpr int NT64 = (NTOK + 63) / 64;
    for (int it = c.b; it < NT64 * 8; it += c.G) {
        const int tile = it >> 3, n = it & 7, t0 = tile * 64;
        __syncthreads();
        for (int i = c.tid; i < 64 * 32; i += NTHR) { const int tk = i >> 5, c4 = (i & 31) * 4; const int t = t0 + tk;
            const f32x4 v = t < NTOK ? *(const f32x4*)(U + (size_t)row_of(t) * 1024 + n * 128 + c4) : (f32x4){0.f, 0.f, 0.f, 0.f}; *(LAS f32x4*)(su + tk * 128 + c4) = v; }
        __syncthreads();
        float aa[16], ai[16];
#pragma unroll
        for (int k = 0; k < 16; ++k) { aa[k] = 0.f; ai[k] = 0.f; }
        const float* wa = p.in[I_RG_WA] + (size_t)n * 16384 + d; const float* wi = p.in[I_RG_WI] + (size_t)n * 16384 + d;
        for (int cc = 0; cc < 128; cc += 4) {
            float wav[4], wiv[4];
#pragma unroll
            for (int j = 0; j < 4; ++j) { wav[j] = wa[(cc + j) * 128]; wiv[j] = wi[(cc + j) * 128]; }
#pragma unroll
            for (int k = 0; k < 16; ++k) { const f32x4 u4 = *(const LAS f32x4*)(su + (sub * 16 + k) * 128 + cc);
#pragma unroll
                for (int j = 0; j < 4; ++j) { aa[k] += u4[j] * wav[j]; ai[k] += u4[j] * wiv[j]; } }
        }
        const int ch = n * 128 + d; const float ba = p.in[I_RG_BA][ch], bi = p.in[I_RG_BI][ch], lam = p.in[I_RG_LAM][ch];
        const float sp = log1pf(__expf(-lam));
#pragma unroll
        for (int k = 0; k < 16; ++k) { const int t = t0 + sub * 16 + k; if (t >= NTOK) continue; const size_t o = (size_t)row_of(t) * 1024 + ch;
            const float r = sigmoidf_(aa[k] + ba), ig = sigmoidf_(ai[k] + bi), la = -8.0f * r * sp;
            A[o] = __expf(la); X[o] = sqrtf(-expm1f(2.0f * la)) * ig * su[(sub * 16 + k) * 128 + d]; }
    }
}
__device__ __forceinline__ void rg_scan_simple(const Params& p, const Ctx& c) {
    const bf16_t* proj = (const bf16_t*)(c.ws + WS_BIG + B_PROJ); const float* A = (const float*)(c.ws + WS_BIG + B_A); const float* X = (const float*)(c.ws + WS_BIG + B_X); bf16_t* MO = (bf16_t*)(c.ws + WS_HN);
    const int ch = c.b * NTHR + c.tid; if (ch >= 1024) return;
    float hs = 0.f;
    for (int t0 = 0; t0 < NTOK; t0 += 16) {
        float a[16], x[16], g[16];
#pragma unroll
        for (int k = 0; k < 16; ++k) { const int row = row_of(t0 + k); a[k] = A[(size_t)row * 1024 + ch]; x[k] = X[(size_t)row * 1024 + ch]; g[k] = bf2f(proj[(size_t)row * N_CDP + 1024 + ch]); }
#pragma unroll
        for (int k = 0; k < 16; ++k) { hs = a[k] * hs + x[k]; MO[(size_t)row_of(t0 + k) * DM + ch] = (bf16_t)f2bf(hs * gelu_tanh(g[k])); }
    }
}

__device__ __forceinline__ size_t sc_off(int q) { const size_t i = (size_t)(q >> 7); return (size_t)16384 * (i * (i + 1) / 2) + (size_t)(q & 127) * ((i + 1) * 128); }
template <int MODE>
__device__ __forceinline__ void bd_gemm(const Params& p, const Ctx& c) {
    constexpr int K = MODE == 1 ? 256 : 128, N = MODE == 1 ? 128 : 256, KP = K + 8, NS = K / 32;
    const bf16_t* proj = (const bf16_t*)(c.ws + WS_BIG + B_PROJ);
    LAS bf16_t* WT = (LAS bf16_t*)c.lds;
    const int ng = c.G >> 3, gidx = c.b & 7, tb = c.b >> 3; if (tb >= ng) return;
    if (MODE == 0) { const float* w = p.in[I_WUK] + gidx * 128;
        for (int i = c.tid; i < 256 * 16; i += NTHR) { const int r = i >> 4, ch = (i & 15) * 8; const f32x4 a = *(const f32x4*)(w + (size_t)r * 1024 + ch), b = *(const f32x4*)(w + (size_t)r * 1024 + ch + 4);
            *(LAS u32x4*)(WT + r * KP + ch) = (u32x4){pk2(a[0], a[1]), pk2(a[2], a[3]), pk2(b[0], b[1]), pk2(b[2], b[3])}; } }
    if (MODE == 1) { const float* w = p.in[I_WUV] + gidx * 128;
        for (int i = c.tid; i < 256 * 32; i += NTHR) { const int r = i >> 5, d4 = (i & 31) * 4; const f32x4 a = *(const f32x4*)(w + (size_t)r * 1024 + d4);
#pragma unroll
            for (int q = 0; q < 4; ++q) WT[(d4 + q) * KP + r] = (bf16_t)f2bf(a[q]); } }
    if (MODE == 2) {
        for (int i = c.tid; i < 2 * 128 * 32; i += NTHR) { const int m = i >> 12, cc = (i >> 5) & 127, d4 = (i & 31) * 4; const f32x4 a = *(const f32x4*)((m ? p.in[I_RG_WI] : p.in[I_RG_WA]) + (size_t)gidx * 16384 + cc * 128 + d4);
#pragma unroll
            for (int q = 0; q < 4; ++q) WT[(m * 128 + d4 + q) * KP + cc] = (bf16_t)f2bf(a[q]); } }
    __syncthreads();
    const int n = c.lane & 15, g = c.lane >> 4, rs = c.wave & 3, hf = c.wave >> 2;
    constexpr int NT64 = (NTOK + 63) / 64;
    for (int tile = tb; tile < NT64; tile += ng) {
        const int t = tile * 64 + 16 * rs + n;
        const int tc = t < NTOK ? t : NTOK - 1;
        bf16x8 af[NS];
        if (MODE == 0) {
#pragma unroll
            for (int s = 0; s < NS; ++s) af[s] = *(const bf16x8*)(proj + (size_t)tc * N_CDP + 2048 + gidx * 128 + 32 * s + 8 * g); }
        if (MODE == 1) { const bf16_t* OL = (const bf16_t*)(c.ws + WS_BIG + B_OL);
#pragma unroll
            for (int s = 0; s < NS; ++s) af[s] = *(const bf16x8*)(OL + (size_t)tc * DM + gidx * 256 + 32 * s + 8 * g); }
        if (MODE == 2) {
#pragma unroll
            for (int s = 0; s < NS; ++s) { const int c0 = gidx * 128 + 32 * s + 8 * g; f32x4 u0 = *(const f32x4*)(p.in[I_RG_CB] + c0), u1 = *(const f32x4*)(p.in[I_RG_CB] + c0 + 4);
#pragma unroll
                for (int jj = 0; jj < 4; ++jj) { const int tp = tc - 3 + jj; if (tp < 0) continue; const u32x4 rx = *(const u32x4*)(proj + (size_t)row_of(tp) * N_CDP + c0);
                    const f32x4 w0 = *(const f32x4*)(p.in[I_RG_CW] + jj * 1024 + c0), w1 = *(const f32x4*)(p.in[I_RG_CW] + jj * 1024 + c0 + 4);
                    u0[0] += w0[0] * bflo(rx.x); u0[1] += w0[1] * bfhi(rx.x); u0[2] += w0[2] * bflo(rx.y); u0[3] += w0[3] * bfhi(rx.y); u1[0] += w1[0] * bflo(rx.z); u1[1] += w1[1] * bfhi(rx.z); u1[2] += w1[2] * bflo(rx.w); u1[3] += w1[3] * bfhi(rx.w); }
                const u32x4 pk = (u32x4){pk2(u0[0], u0[1]), pk2(u0[2], u0[3]), pk2(u1[0], u1[1]), pk2(u1[2], u1[3])}; af[s] = __builtin_bit_cast(bf16x8, pk); asm volatile("" ::: "memory"); } }
        constexpr int NTL = MODE == 0 ? 8 : 4;
#pragma unroll
        for (int i = 0; i < NTL; ++i) {
            const int nt = hf * NTL + i;
            f32x4 acc = (f32x4){0.f, 0.f, 0.f, 0.f}, acc2 = (f32x4){0.f, 0.f, 0.f, 0.f};
#pragma unroll
            for (int s = 0; s < NS; ++s) { const bf16x8 wf = *(const LAS bf16x8*)(WT + (16 * nt + n) * KP + 32 * s + 8 * g); acc = __builtin_amdgcn_mfma_f32_16x16x32_bf16(wf, af[s], acc, 0, 0, 0);
                if (MODE == 2) { const bf16x8 wf2 = *(const LAS bf16x8*)(WT + (128 + 16 * nt + n) * KP + 32 * s + 8 * g); acc2 = __builtin_amdgcn_mfma_f32_16x16x32_bf16(wf2, af[s], acc2, 0, 0, 0); } }
            if (t < NTOK) {
                const int col = 16 * nt + 4 * g;
                if (MODE == 0) { bf16_t* QL = (bf16_t*)(c.ws + WS_QL); const float sc = 0.08838834764831845f;
                    *(u32x2*)(QL + (size_t)t * DM + gidx * 256 + col) = (u32x2){pk2(acc[0] * sc, acc[1] * sc), pk2(acc[2] * sc, acc[3] * sc)}; }
                if (MODE == 1) { bf16_t* MO = (bf16_t*)(c.ws + WS_HN); *(u32x2*)(MO + (size_t)t * DM + 1024 + gidx * 128 + col) = (u32x2){pk2(acc[0], acc[1]), pk2(acc[2], acc[3])}; }
                if (MODE == 2) { float* A = (float*)(c.ws + WS_BIG + B_A); float* X = (float*)(c.ws + WS_BIG + B_X); const int ch = gidx * 128 + col;
                    f32x4 u = *(const f32x4*)(p.in[I_RG_CB] + ch);
#pragma unroll
                    for (int jj = 0; jj < 4; ++jj) { const int tp = t - 3 + jj; if (tp < 0) continue; const u32x2 rx = *(const u32x2*)(proj + (size_t)row_of(tp) * N_CDP + ch); const f32x4 w0 = *(const f32x4*)(p.in[I_RG_CW] + jj * 1024 + ch);
                        u[0] += w0[0] * bflo(rx.x); u[1] += w0[1] * bfhi(rx.x); u[2] += w0[2] * bflo(rx.y); u[3] += w0[3] * bfhi(rx.y); }
                    const f32x4 ba = *(const f32x4*)(p.in[I_RG_BA] + ch), bi = *(const f32x4*)(p.in[I_RG_BI] + ch), lam = *(const f32x4*)(p.in[I_RG_LAM] + ch);
                    f32x4 av, xv;
#pragma unroll
                    for (int r = 0; r < 4; ++r) { const float rg = sigmoidf_(acc[r] + ba[r]), ig = sigmoidf_(acc2[r] + bi[r]), la = -8.0f * rg * __logf(1.0f + __expf(-lam[r])); const float aa = __expf(la); av[r] = aa; xv[r] = __builtin_amdgcn_sqrtf(fmaxf(1.0f - aa * aa, 0.f)) * ig * u[r]; }
                    const size_t o = (size_t)row_of(t) * 1024 + ch; *(f32x4*)(A + o) = av; *(f32x4*)(X + o) = xv; }
            }
        }
    }
    __syncthreads();
}

__device__ __forceinline__ void phase_gates_v2(const Params& p, const Ctx& c) {
    constexpr int KP = 136;
    const bf16_t* proj = (const bf16_t*)(c.ws + WS_BIG + B_PROJ); float* A = (float*)(c.ws + WS_BIG + B_A); float* X = (float*)(c.ws + WS_BIG + B_X); float* SUM = (float*)(c.ws + WS_BIG + B_U);
    LAS bf16_t* WT = (LAS bf16_t*)c.lds;
    LAS bf16_t* UB = WT + 256 * KP;
    LAS float* LA = (LAS float*)(UB + 64 * KP);
    LAS bf16_t* LX = (LAS bf16_t*)(LA + 64 * 132);
    LAS float* PS = (LAS float*)(LX + 64 * KP);
    const int ng = c.G >> 3, gidx = c.b & 7, tb = c.b >> 3; if (tb >= ng) return;
    for (int i = c.tid; i < 2 * 128 * 32; i += NTHR) { const int m = i >> 12, cc = (i >> 5) & 127, d4 = (i & 31) * 4; const f32x4 a = *(const f32x4*)((m ? p.in[I_RG_WI] : p.in[I_RG_WA]) + (size_t)gidx * 16384 + cc * 128 + d4);
#pragma unroll
        for (int q = 0; q < 4; ++q) WT[(m * 128 + d4 + q) * KP + cc] = (bf16_t)f2bf(a[q]); }
    const int tk = c.tid >> 3, cb = (c.tid & 7) * 16, ch0 = gidx * 128 + cb;
    LAS float* CW = PS + 4 * 128 * 2;
    for (int i = c.tid; i < 5 * 128; i += NTHR) { const int jj = i >> 7, cc = i & 127; CW[i] = jj < 4 ? p.in[I_RG_CW][jj * 1024 + gidx * 128 + cc] : p.in[I_RG_CB][gidx * 128 + cc]; }
    __syncthreads();
    const int n = c.lane & 15, g = c.lane >> 4, rs = c.wave & 3, hf = c.wave >> 2;
    f32x4 ba4[4], bi4[4], sp4[4];
#pragma unroll
    for (int i = 0; i < 4; ++i) { const int ch = gidx * 128 + 16 * (hf * 4 + i) + 4 * g; ba4[i] = *(const f32x4*)(p.in[I_RG_BA] + ch); bi4[i] = *(const f32x4*)(p.in[I_RG_BI] + ch); const f32x4 lam = *(const f32x4*)(p.in[I_RG_LAM] + ch);
#pragma unroll
        for (int r = 0; r < 4; ++r) sp4[i][r] = -8.0f * __logf(1.0f + __expf(-lam[r])); }
    constexpr int NT64 = (NTOK + 63) / 64;
    u32x4 rx[4][2];
    { const int t = min(tb * 64 + tk, NTOK - 1);
#pragma unroll
      for (int jj = 0; jj < 4; ++jj) { const int tp = t - 3 + jj; const bf16_t* s = proj + (size_t)row_of(tp < 0 ? 0 : tp) * N_CDP + ch0; rx[jj][0] = *(const u32x4*)s; rx[jj][1] = *(const u32x4*)(s + 8); } }
    for (int tile = tb; tile < NT64; tile += ng) {
        const int tq = tile * 64 + tk;
        float u[16];
#pragma unroll
        for (int i4 = 0; i4 < 4; ++i4) { const f32x4 bv = *(const LAS f32x4*)(CW + 4 * 128 + cb + 4 * i4); u[4 * i4] = bv[0]; u[4 * i4 + 1] = bv[1]; u[4 * i4 + 2] = bv[2]; u[4 * i4 + 3] = bv[3]; }
#pragma unroll
        for (int jj = 0; jj < 4; ++jj) { if (tq - 3 + jj < 0) continue;
            const unsigned wv[8] = {rx[jj][0].x, rx[jj][0].y, rx[jj][0].z, rx[jj][0].w, rx[jj][1].x, rx[jj][1].y, rx[jj][1].z, rx[jj][1].w};
#pragma unroll
            for (int i4 = 0; i4 < 4; ++i4) { const f32x4 wq = *(const LAS f32x4*)(CW + jj * 128 + cb + 4 * i4);
                u[4 * i4] += wq[0] * bflo(wv[2 * i4]); u[4 * i4 + 1] += wq[1] * bfhi(wv[2 * i4]); u[4 * i4 + 2] += wq[2] * bflo(wv[2 * i4 + 1]); u[4 * i4 + 3] += wq[3] * bfhi(wv[2 * i4 + 1]); } }
        __syncthreads();
        *(LAS u32x4*)(UB + tk * KP + cb) = (u32x4){pk2(u[0], u[1]), pk2(u[2], u[3]), pk2(u[4], u[5]), pk2(u[6], u[7])};
        *(LAS u32x4*)(UB + tk * KP + cb + 8) = (u32x4){pk2(u[8], u[9]), pk2(u[10], u[11]), pk2(u[12], u[13]), pk2(u[14], u[15])};
        if (tile + ng < NT64) { const int t = min((tile + ng) * 64 + tk, NTOK - 1);
#pragma unroll
            for (int jj = 0; jj < 4; ++jj) { const int tp = t - 3 + jj; const bf16_t* s = proj + (size_t)row_of(tp < 0 ? 0 : tp) * N_CDP + ch0; rx[jj][0] = *(const u32x4*)s; rx[jj][1] = *(const u32x4*)(s + 8); } }
        __syncthreads();
        const int t = tile * 64 + 16 * rs + n;
        bf16x8 af[4];
#pragma unroll
        for (int s = 0; s < 4; ++s) af[s] = *(const LAS bf16x8*)(UB + (16 * rs + n) * KP + 32 * s + 8 * g);
#pragma unroll
        for (int i = 0; i < 4; ++i) {
            const int nt = hf * 4 + i;
            f32x4 acc = (f32x4){0.f, 0.f, 0.f, 0.f}, acc2 = (f32x4){0.f, 0.f, 0.f, 0.f};
#pragma unroll
            for (int s = 0; s < 4; ++s) { const bf16x8 wf = *(const LAS bf16x8*)(WT + (16 * nt + n) * KP + 32 * s + 8 * g); acc = __builtin_amdgcn_mfma_f32_16x16x32_bf16(wf, af[s], acc, 0, 0, 0);
                const bf16x8 wf2 = *(const LAS bf16x8*)(WT + (128 + 16 * nt + n) * KP + 32 * s + 8 * g); acc2 = __builtin_amdgcn_mfma_f32_16x16x32_bf16(wf2, af[s], acc2, 0, 0, 0); }
            {
                const int col = 16 * nt + 4 * g; const u32x2 ub = *(const LAS u32x2*)(UB + (16 * rs + n) * KP + col); const float uu[4] = {bflo(ub.x), bfhi(ub.x), bflo(ub.y), bfhi(ub.y)};
                f32x4 lav, xv;
#pragma unroll
                for (int r = 0; r < 4; ++r) { const float rg = sigmoidf_(acc[r] + ba4[i][r]), ig = sigmoidf_(acc2[r] + bi4[i][r]); const float la = rg * sp4[i][r], aa = __expf(la);
                    lav[r] = t < NTOK ? la : 0.f; xv[r] = t < NTOK ? __builtin_amdgcn_sqrtf(fmaxf(1.0f - aa * aa, 0.f)) * ig * uu[r] : 0.f; }
                *(LAS f32x4*)(LA + (16 * rs + n) * 132 + col) = lav; *(LAS u32x2*)(LX + (16 * rs + n) * KP + col) = (u32x2){pk2(xv[0], xv[1]), pk2(xv[2], xv[3])};
            }
        }
        __syncthreads();
        { const int ch = c.tid & 127, part = c.tid >> 7, gch = gidx * 128 + ch;
          float lak[16], xk[16]; float h = 0.f, cl = 0.f;
#pragma unroll
          for (int k = 0; k < 16; ++k) { lak[k] = LA[(16 * part + k) * 132 + ch]; xk[k] = bf2f(LX[(16 * part + k) * KP + ch]); h = __expf(lak[k]) * h + xk[k]; cl += lak[k]; }
          PS[(part * 128 + ch) * 2] = h; PS[(part * 128 + ch) * 2 + 1] = cl;
          __syncthreads();
          float hin = 0.f, lin = 0.f;
#pragma unroll
          for (int pp = 0; pp < 3; ++pp) if (pp < part) { const float hp = PS[(pp * 128 + ch) * 2], lp = PS[(pp * 128 + ch) * 2 + 1]; hin = __expf(lp) * hin + hp; lin += lp; }
          h = hin; cl = lin;
#pragma unroll
          for (int k = 0; k < 16; ++k) { h = __expf(lak[k]) * h + xk[k]; cl += lak[k]; const int tt = tile * 64 + 16 * part + k;
              if (tt < NTOK) { const size_t o = (size_t)row_of(tt) * 1024 + gch; __builtin_nontemporal_store(h, X + o); __builtin_nontemporal_store(__expf(cl), A + o); } }
          if (part == 3) { SUM[(size_t)(tile * 2) * 1024 + gch] = __expf(cl); SUM[(size_t)(tile * 2 + 1) * 1024 + gch] = h; } }
    }
    __syncthreads();
}

constexpr int RG_NT = (NTOK + 63) / 64;
__device__ __forceinline__ void rg_scan_s1(const Params& p, const Ctx& c) {
    float* A = (float*)(c.ws + WS_BIG + B_A); float* X = (float*)(c.ws + WS_BIG + B_X); float* SUM = (float*)(c.ws + WS_BIG + B_U);
    for (int it = c.b; it < RG_NT * 2; it += c.G) {
        const int tile = it >> 1, ch = (it & 1) * NTHR + c.tid, t0 = tile * 64, nt = min(64, NTOK - t0);
        float hs = 0.f, pr = 1.f;
        for (int k0 = 0; k0 < nt; k0 += 16) {
            float a[16], x[16];
#pragma unroll
            for (int k = 0; k < 16; ++k) { const size_t o = (size_t)row_of(t0 + k0 + k) * 1024 + ch; a[k] = A[o]; x[k] = X[o]; }
#pragma unroll
            for (int k = 0; k < 16; ++k) { const size_t o = (size_t)row_of(t0 + k0 + k) * 1024 + ch; hs = a[k] * hs + x[k]; pr *= a[k]; X[o] = hs; A[o] = pr; }
        }
        SUM[(size_t)(tile * 2) * 1024 + ch] = pr; SUM[(size_t)(tile * 2 + 1) * 1024 + ch] = hs;
    }
}
__device__ __forceinline__ void rg_scan_s2(const Params& p, const Ctx& c) {
    float* SUM = (float*)(c.ws + WS_BIG + B_U);
    const int ch = c.b * NTHR + c.tid; if (ch >= 1024) return;
    float carry = 0.f;
    for (int t0 = 0; t0 < RG_NT; t0 += 16) {
        float pr[16], hs[16];
#pragma unroll
        for (int k = 0; k < 16; ++k) { const int tile = t0 + k; if (tile < RG_NT) { pr[k] = SUM[(size_t)(tile * 2) * 1024 + ch]; hs[k] = SUM[(size_t)(tile * 2 + 1) * 1024 + ch]; } else { pr[k] = 1.f; hs[k] = 0.f; } }
#pragma unroll
        for (int k = 0; k < 16; ++k) { const int tile = t0 + k; if (tile < RG_NT) { SUM[(size_t)(tile * 2) * 1024 + ch] = carry; carry = pr[k] * carry + hs[k]; } }
    }
}
__device__ __forceinline__ void rg_scan_s23(const Params& p, const Ctx& c) {
    const bf16_t* proj = (const bf16_t*)(c.ws + WS_BIG + B_PROJ); const float* A = (const float*)(c.ws + WS_BIG + B_A); const float* X = (const float*)(c.ws + WS_BIG + B_X); const float* SUM = (const float*)(c.ws + WS_BIG + B_U);
    bf16_t* MO = (bf16_t*)(c.ws + WS_HN);
    for (int it = c.b * NWAVES + c.wave; it < RG_NT * 16; it += c.G * NWAVES) {
        const int tile = RG_NT - 1 - (it >> 4), ch = (it & 15) * 64 + c.lane, t0 = tile * 64, nt = min(64, NTOK - t0);
        float carry = 0.f;
        for (int tp = 0; tp < tile; tp += 8) {
            float pr[8], hs[8];
#pragma unroll
            for (int k = 0; k < 8; ++k) { const int tt = min(tp + k, tile - 1); pr[k] = SUM[(size_t)(tt * 2) * 1024 + ch]; hs[k] = SUM[(size_t)(tt * 2 + 1) * 1024 + ch]; }
#pragma unroll
            for (int k = 0; k < 8; ++k) if (tp + k < tile) carry = pr[k] * carry + hs[k];
        }
        for (int k0 = 0; k0 < nt; k0 += 16) {
            float pv[16], hl[16], g[16];
#pragma unroll
            for (int k = 0; k < 16; ++k) { const int row = row_of(t0 + k0 + k); pv[k] = __builtin_nontemporal_load(A + (size_t)row * 1024 + ch); hl[k] = __builtin_nontemporal_load(X + (size_t)row * 1024 + ch); g[k] = bf2f(proj[(size_t)row * N_CDP + 1024 + ch]); }
#pragma unroll
            for (int k = 0; k < 16; ++k) { const int row = row_of(t0 + k0 + k); MO[(size_t)row * DM + ch] = (bf16_t)f2bf((hl[k] + pv[k] * carry) * gelu_tanh(g[k])); }
        }
    }
}

__device__ __forceinline__ void phase_scores_mfma(const Params& p, const Ctx& c) {
    const bf16_t* proj = (const bf16_t*)(c.ws + WS_BIG + B_PROJ); float* SC = (float*)(c.ws + WS_BIG + B_SC);
    const int n = c.lane & 15, g = c.lane >> 4;
    for (int it = c.b; it < NREAL / 32; it += c.G) {
        const int q0 = (NREAL / 32 - 1 - it) * 32 + c.wave * 4;
        bf16x8 a[4][2]; f32x4 w[4];
#pragma unroll
        for (int qq = 0; qq < 4; ++qq) { const bf16_t* pr = proj + (size_t)(q0 + qq) * N_CDP;
            a[qq][0] = *(const bf16x8*)(pr + 3328 + n * 64 + 8 * g); a[qq][1] = *(const bf16x8*)(pr + 3328 + n * 64 + 32 + 8 * g);
            const u32x2 wv = *(const u32x2*)(pr + 4416 + 4 * g); w[qq] = (f32x4){bflo(wv.x), bfhi(wv.x), bflo(wv.y), bfhi(wv.y)} * 0.03125f; }
        const int ntile = (q0 + 3) / 16 + 1;
        size_t off[4]; int lim[4];
#pragma unroll
        for (int qq = 0; qq < 4; ++qq) { off[qq] = sc_off(q0 + qq); lim[qq] = (((q0 + qq) >> 7) + 1) * 128; }
        for (int kt = 0; kt < ntile; ++kt) {
            const bf16_t* kr = proj + (size_t)(kt * 16 + n) * N_CDP + 4352 + 8 * g;
            const bf16x8 b0 = *(const bf16x8*)kr, b1 = *(const bf16x8*)(kr + 32);
#pragma unroll
            for (int qq = 0; qq < 4; ++qq) {
                f32x4 acc = (f32x4){0.f, 0.f, 0.f, 0.f};
                acc = __builtin_amdgcn_mfma_f32_16x16x32_bf16(a[qq][0], b0, acc, 0, 0, 0); acc = __builtin_amdgcn_mfma_f32_16x16x32_bf16(a[qq][1], b1, acc, 0, 0, 0);
                float s = fmaxf(acc[0], 0.f) * w[qq][0] + fmaxf(acc[1], 0.f) * w[qq][1] + fmaxf(acc[2], 0.f) * w[qq][2] + fmaxf(acc[3], 0.f) * w[qq][3];
                s += __shfl_xor(s, 16); s += __shfl_xor(s, 32);
                const int key = kt * 16 + n; if (g == 0 && key < lim[qq]) SC[off[qq] + key] = s;
            }
        }
    }
}

__device__ __forceinline__ void phase_scores_simple(const Params& p, const Ctx& c) {
    const bf16_t* proj = (const bf16_t*)(c.ws + WS_BIG + B_PROJ); float* SC = (float*)(c.ws + WS_BIG + B_SC);
    LAS float* siq = (LAS float*)c.lds;
    LAS float* sw = siq + 16384;
    int id = 0;
    for (int qt = 0; qt < NREAL / 16; ++qt) {
        const int q0 = qt * 16, nch = (q0 + 15) / 512 + 1;
        for (int kc = 0; kc < nch; ++kc, ++id) {
            if (id % c.G != c.b) continue;
            __syncthreads();
            for (int i = c.tid; i < 16 * 128; i += NTHR) { const int qq = i >> 7, c8 = (i & 127) * 8; const u32x4 v = *(const u32x4*)(proj + (size_t)(q0 + qq) * N_CDP + 3328 + c8);
                LAS float* d = siq + qq * 1024 + c8; d[0] = bflo(v.x); d[1] = bfhi(v.x); d[2] = bflo(v.y); d[3] = bfhi(v.y); d[4] = bflo(v.z); d[5] = bfhi(v.z); d[6] = bflo(v.w); d[7] = bfhi(v.w); }
            if (c.tid < 256) sw[c.tid] = bf2f(proj[(size_t)(q0 + (c.tid >> 4)) * N_CDP + 4416 + (c.tid & 15)]);
            __syncthreads();
            const int s = kc * 512 + c.tid;
            if (s <= q0 + 15) {
                float ik[64];
#pragma unroll
                for (int j = 0; j < 8; ++j) { const u32x4 v = *(const u32x4*)(proj + (size_t)s * N_CDP + 4352 + j * 8);
                    ik[j * 8 + 0] = bflo(v.x); ik[j * 8 + 1] = bfhi(v.x); ik[j * 8 + 2] = bflo(v.y); ik[j * 8 + 3] = bfhi(v.y); ik[j * 8 + 4] = bflo(v.z); ik[j * 8 + 5] = bfhi(v.z); ik[j * 8 + 6] = bflo(v.w); ik[j * 8 + 7] = bfhi(v.w); }
                for (int qq = 0; qq < 16; ++qq) {
                    float sc = 0.f;
                    for (int h = 0; h < 16; ++h) {
                        const LAS f32x4* a = (const LAS f32x4*)(siq + qq * 1024 + h * 64); float d = 0.f;
#pragma unroll
                        for (int j = 0; j < 16; ++j) { const f32x4 av = a[j]; d += av[0] * ik[4 * j] + av[1] * ik[4 * j + 1] + av[2] * ik[4 * j + 2] + av[3] * ik[4 * j + 3]; }
                        sc += fmaxf(d, 0.f) * sw[qq * 16 + h];
                    }
                    const int q = q0 + qq; if (s < ((q >> 7) + 1) * 128) SC[sc_off(q) + s] = sc * 0.03125f;
                }
            }
        }
    }
}
__device__ __forceinline__ void phase_select(const Params& p, const Ctx& c) {
    const float* SC = (const float*)(c.ws + WS_BIG + B_SC); int* IDX = (int*)(c.ws + WS_IDX);
    LAS int* sc0 = (LAS int*)c.lds;
    LAS int* sc1 = sc0 + 16;
    const unsigned long long lt_mask = (1ull << c.lane) - 1ull;
    for (int q = c.b; q < NREAL; q += c.G) {
        int* out = IDX + (size_t)q * 256;
        if (q < 256) { if (c.tid < 256) out[c.tid] = c.tid <= q ? c.tid : -1; continue; }
        __syncthreads();
        const float* row = SC + sc_off(q);
        unsigned key[16];
#pragma unroll
        for (int j = 0; j < 16; ++j) { const int s = j * 512 + c.tid; unsigned k = 0u; if (s <= q) { const unsigned b = __float_as_uint(row[s]); k = (b & 0x80000000u) ? ~b : (b | 0x80000000u); } key[j] = k; }
        unsigned prefix = 0u;
        for (int bit = 31; bit >= 0; --bit) {
            const unsigned cand = prefix | (1u << bit); int cnt = 0;
#pragma unroll
            for (int j = 0; j < 16; ++j) cnt += __popcll(__ballot(key[j] >= cand));
            LAS int* buf = sc0 + (bit & 1) * 8;
            if (c.lane == 0) buf[c.wave] = cnt;
            __syncthreads();
            int tot = 0;
#pragma unroll
            for (int w = 0; w < 8; ++w) tot += buf[w];
            if (tot >= 256) prefix = cand;
            if (tot == 256) break;
        }
        int cg = 0, ce = 0;
#pragma unroll
        for (int j = 0; j < 16; ++j) { cg += __popcll(__ballot(key[j] > prefix)); ce += __popcll(__ballot(key[j] == prefix)); }
        if (c.lane == 0) { sc1[c.wave] = cg; sc1[8 + c.wave] = ce; }
        __syncthreads();
        int totg = 0, tote = 0;
#pragma unroll
        for (int w = 0; w < 8; ++w) { totg += sc1[w]; tote += sc1[8 + w]; }
        const int need = 256 - totg;
        unsigned takebits = 0u;
        if (need >= tote) {
#pragma unroll
            for (int j = 0; j < 16; ++j) takebits |= (key[j] >= prefix ? 1u : 0u) << j;
        } else {
            int eq_seen = 0;
            for (int j = 0; j < 16; ++j) {
                unsigned kj = 0u;
#pragma unroll
                for (int jj = 0; jj < 16; ++jj) kj = jj == j ? key[jj] : kj;
                const bool eq = kj == prefix; const unsigned long long meq = __ballot(eq);
                __syncthreads();
                if (c.lane == 0) sc0[c.wave] = __popcll(meq);
                __syncthreads();
                int base = eq_seen, all = 0;
#pragma unroll
                for (int w = 0; w < 8; ++w) { const int v = sc0[w]; base += w < c.wave ? v : 0; all += v; }
                const bool take = kj > prefix || (eq && base + __popcll(meq & lt_mask) < need);
                takebits |= (take ? 1u : 0u) << j; eq_seen += all;
            }
        }
        int tk = 0;
#pragma unroll
        for (int j = 0; j < 16; ++j) tk += __popcll(__ballot((takebits >> j) & 1u));
        if (c.lane == 0) sc1[16 + c.wave] = tk;
        __syncthreads();
        int pos = 0;
#pragma unroll
        for (int w = 0; w < 8; ++w) pos += w < c.wave ? sc1[16 + w] : 0;
#pragma unroll
        for (int j = 0; j < 16; ++j) { const bool t = (takebits >> j) & 1u; const unsigned long long mt = __ballot(t);
            if (t) out[pos + __popcll(mt & lt_mask)] = j * 512 + c.tid;
            pos += __popcll(mt); }
    }
}
__device__ __forceinline__ unsigned sel_key(float x) { const unsigned b = __float_as_uint(x); return (b & 0x80000000u) ? ~b : (b | 0x80000000u); }
__device__ __forceinline__ float relu_i(float x) { return __int_as_float(max(__float_as_int(x), 0)); }
__device__ __forceinline__ void phase_scores_v2(const Params& p, const Ctx& c) {
    const bf16_t* proj = (const bf16_t*)(c.ws + WS_BIG + B_PROJ); float* SC = (float*)(c.ws + WS_BIG + B_SC); unsigned short* GM = (unsigned short*)(c.ws + WS_GM);
    const int n = c.lane & 15, g = c.lane >> 4;
    constexpr int NITEM = 2176, KP = 72;
    LAS bf16_t* kb = (LAS bf16_t*)c.lds;
    LAS float* gx = (LAS float*)(kb + 2 * 256 * KP);
    const int lkey = c.tid >> 1, lhalf = c.tid & 1;
    const int qset = c.wave & 3, khalf = c.wave >> 2;
    for (int id = c.b; id < NITEM; id += c.G) {
        const int rid = NITEM - 1 - id;
        int a = 0; while (a < 15 && 8 * (a + 1) * (a + 2) <= rid) ++a;
        const int rem = rid - 8 * a * (a + 1), qt = 16 * a + rem / (a + 1), kc = rem % (a + 1);
        const int q0 = qt * 32 + qset * 8;
        bf16x8 af[8][2]; u32x2 wp[8];
#pragma unroll
        for (int qq = 0; qq < 8; ++qq) { const bf16_t* pr = proj + (size_t)(q0 + qq) * N_CDP;
            af[qq][0] = *(const bf16x8*)(pr + 3328 + n * 64 + 8 * g); af[qq][1] = *(const bf16x8*)(pr + 3328 + n * 64 + 32 + 8 * g);
            wp[qq] = *(const u32x2*)(pr + 4416 + 4 * g); }
        const int g0 = kc * 8, g1 = min(g0 + 8, (qt * 32 + 31) / 64 + 1);
        const int nss = (g1 - g0 + 3) >> 2;
        const int lim = ((q0 >> 7) + 1) * 128;
        const size_t off0 = sc_off(q0); const int pitch = lim;
        float gmx[8];
#pragma unroll
        for (int qq = 0; qq < 8; ++qq) gmx[qq] = -INFINITY;
        u32x4 st[4];
        { const bf16_t* src = proj + (size_t)(g0 * 64 + lkey) * N_CDP + 4352 + lhalf * 32;
#pragma unroll
          for (int i = 0; i < 4; ++i) st[i] = *(const u32x4*)(src + 8 * i); }
        __syncthreads();
        for (int ss = 0; ss < nss; ++ss) {
            LAS bf16_t* buf = kb + (ss & 1) * 256 * KP;
#pragma unroll
            for (int i = 0; i < 4; ++i) *(LAS u32x4*)(buf + lkey * KP + lhalf * 32 + 8 * i) = st[i];
            if (ss + 1 < nss) { const bf16_t* src = proj + (size_t)((g0 + 4 * (ss + 1)) * 64 + lkey) * N_CDP + 4352 + lhalf * 32;
#pragma unroll
                for (int i = 0; i < 4; ++i) st[i] = *(const u32x4*)(src + 8 * i); }
            __syncthreads();
            const int nk = min(4, g1 - g0 - 4 * ss);
#ifndef SCDUP
#define SCDUP 1
#endif
            for (int dup_ = 0; dup_ < SCDUP; ++dup_)
            for (int kl = 2 * khalf; kl < min(nk, 2 * khalf + 2); ++kl) {
                const int kg = g0 + 4 * ss + kl; const int key = kg * 64 + c.lane;
                bf16x8 cb[4][2];
#pragma unroll
                for (int t = 0; t < 4; ++t) { cb[t][0] = *(const LAS bf16x8*)(buf + (kl * 64 + 16 * t + n) * KP + 8 * g); cb[t][1] = *(const LAS bf16x8*)(buf + (kl * 64 + 16 * t + n) * KP + 32 + 8 * g); }
#pragma unroll
                for (int h = 0; h < 4; ++h) {
                    f32x4 acc[2][4];
#pragma unroll
                    for (int qq = 0; qq < 2; ++qq)
#pragma unroll
                        for (int t = 0; t < 4; ++t) acc[qq][t] = __builtin_amdgcn_mfma_f32_16x16x32_bf16(af[2 * h + qq][0], cb[t][0], (f32x4){0.f, 0.f, 0.f, 0.f}, 0, 0, 0);
#pragma unroll
                    for (int qq = 0; qq < 2; ++qq)
#pragma unroll
                        for (int t = 0; t < 4; ++t) acc[qq][t] = __builtin_amdgcn_mfma_f32_16x16x32_bf16(af[2 * h + qq][1], cb[t][1], acc[qq][t], 0, 0, 0);
                    float sq[2][4];
#pragma unroll
                    for (int qq = 0; qq < 2; ++qq) { const u32x2 wv = wp[2 * h + qq]; const float w0 = bflo(wv.x) * 0.03125f, w1 = bfhi(wv.x) * 0.03125f, w2 = bflo(wv.y) * 0.03125f, w3 = bfhi(wv.y) * 0.03125f;
#pragma unroll
                        for (int t = 0; t < 4; ++t) sq[qq][t] = relu_i(acc[qq][t][0]) * w0 + relu_i(acc[qq][t][1]) * w1 + relu_i(acc[qq][t][2]) * w2 + relu_i(acc[qq][t][3]) * w3; }
#pragma unroll
                    for (int qq = 0; qq < 2; ++qq) { const int qi = 2 * h + qq;
                        auto s01 = __builtin_amdgcn_permlane16_swap(__float_as_uint(sq[qq][0]), __float_as_uint(sq[qq][1]), false, false);
                        auto s23 = __builtin_amdgcn_permlane16_swap(__float_as_uint(sq[qq][2]), __float_as_uint(sq[qq][3]), false, false);
                        const float e01 = __uint_as_float(s01[0]) + __uint_as_float(s01[1]), e23 = __uint_as_float(s23[0]) + __uint_as_float(s23[1]);
                        auto su = __builtin_amdgcn_permlane32_swap(__float_as_uint(e01), __float_as_uint(e23), false, false);
                        const float sv = __uint_as_float(su[0]) + __uint_as_float(su[1]);
                        if (key < lim) __builtin_nontemporal_store(sv, SC + off0 + (size_t)qi * pitch + key);
                        if (key <= q0 + qi) gmx[qi] = fmaxf(gmx[qi], sv);
                    }
                }
            }
        }
        if (khalf == 1) {
#pragma unroll
            for (int qq = 0; qq < 8; ++qq) gx[(qset * 8 + qq) * 64 + c.lane] = gmx[qq]; }
        __syncthreads();
        if (khalf == 0) {
#pragma unroll
            for (int qq = 0; qq < 8; ++qq) { const float m = fmaxf(gmx[qq], gx[(qset * 8 + qq) * 64 + c.lane]);
                GM[((size_t)(q0 + qq) * 16 + kc) * 64 + c.lane] = (unsigned short)(m == -INFINITY ? 0u : (sel_key(m) >> 16)); } }
    }
    __syncthreads();
}
__device__ __forceinline__ int wave_isum(int v) {
#pragma unroll
    for (int o = 1; o < 64; o <<= 1) v += __shfl_xor(v, o);
    return v;
}
template <int NS>
__device__ __forceinline__ void select_group(const Ctx& c, const float* SC, int* IDX, int q0) {
    LAS int* cnt = (LAS int*)c.lds;
    LAS int* aux = cnt + 16;
    const int rr = c.wave >> 1, hw = c.wave & 1, q = q0 + rr, l128 = hw * 64 + c.lane;
    const unsigned long long lt_mask = (1ull << c.lane) - 1ull;
    const float* row = SC + sc_off(q); int* out = IDX + (size_t)q * 256;
    unsigned key[NS];
#pragma unroll
    for (int j = 0; j < NS; ++j) { const int s = j * 128 + l128; key[j] = s <= q ? sel_key(row[s]) : 0u; }
    unsigned prefix = 0u; bool done = false;
#pragma nounroll
    for (int bit = 31; bit >= 0; --bit) {
        const unsigned cand = prefix | (1u << bit); int cn = 0;
        if (!done) {
#pragma unroll
            for (int j0 = 0; j0 < NS; j0 += 8) { int part = 0;
#pragma unroll
                for (int j = j0; j < j0 + 8; ++j) part += __popcll(__ballot(key[j] >= cand));
                cn += part; asm volatile("" : "+s"(cn)); } }
        LAS int* buf = cnt + (bit & 1) * 8;
        if (c.lane == 0) buf[c.wave] = done ? -1 : cn;
        __syncthreads();
        if (!done) { const int tot = buf[2 * rr] + buf[2 * rr + 1]; if (tot >= 256) prefix = cand; if (tot == 256) done = true; }
        bool alld = true;
#pragma unroll
        for (int w = 0; w < 8; ++w) alld = alld && (buf[w] == -1);
        if (alld) break;
    }
    int cg = 0, ce = 0;
#pragma unroll
    for (int j = 0; j < NS; ++j) { cg += key[j] > prefix ? 1 : 0; ce += key[j] == prefix ? 1 : 0; }
    cg = wave_isum(cg); ce = wave_isum(ce);
    __syncthreads();
    if (c.lane == 0) { aux[c.wave] = cg; aux[8 + c.wave] = ce; }
    __syncthreads();
    const int need = 256 - (aux[2 * rr] + aux[2 * rr + 1]);
    bool anytie = false;
#pragma unroll
    for (int r2 = 0; r2 < 4; ++r2) anytie = anytie || (256 - (aux[2 * r2] + aux[2 * r2 + 1]) < aux[8 + 2 * r2] + aux[8 + 2 * r2 + 1]);
    int T = NREAL;
    if (anytie) {
        int lo = 0, hi = NREAL - 1;
#pragma nounroll
        for (int it = 0; it < 13; ++it) {
            const int mid = (lo + hi) >> 1; int cn = 0;
#pragma unroll
            for (int j = 0; j < NS; ++j) cn += (key[j] == prefix && j * 128 + l128 <= mid) ? 1 : 0;
            cn = wave_isum(cn);
            __syncthreads();
            if (c.lane == 0) cnt[c.wave] = cn;
            __syncthreads();
            if (cnt[2 * rr] + cnt[2 * rr + 1] >= need) hi = mid; else lo = mid + 1;
        }
        T = lo;
    }
    int tk = 0;
#pragma unroll
    for (int j = 0; j < NS; ++j) tk += (key[j] > prefix || (key[j] == prefix && j * 128 + l128 <= T)) ? 1 : 0;
    tk = wave_isum(tk);
    __syncthreads();
    if (c.lane == 0) aux[16 + c.wave] = tk;
    __syncthreads();
    int pos = hw ? aux[16 + 2 * rr] : 0;
#pragma unroll
    for (int j = 0; j < NS; ++j) { const bool t = key[j] > prefix || (key[j] == prefix && j * 128 + l128 <= T); const unsigned long long mt = __ballot(t);
        if (t) out[pos + __popcll(mt & lt_mask)] = j * 128 + l128;
        pos += __popcll(mt); }
    __syncthreads();
}
constexpr int SEL_CAP = 2048;
__device__ __forceinline__ void select_row_slow(const Ctx& c, const float* row, int q, int* out) {
    const unsigned long long lt_mask = (1ull << c.lane) - 1ull; const int slots = (q + 64) >> 6; unsigned prefix = 0u;
    for (int bit = 31; bit >= 0; --bit) { const unsigned cand = prefix | (1u << bit); int cnt = 0;
        for (int j = 0; j < slots; ++j) { const int s = j * 64 + c.lane; const unsigned k = s <= q ? sel_key(row[s]) : 0u; cnt += __popcll(__ballot(k >= cand)); }
        if (cnt >= 256) prefix = cand; }
    int cgt = 0;
    for (int j = 0; j < slots; ++j) { const int s = j * 64 + c.lane; const unsigned k = s <= q ? sel_key(row[s]) : 0u; cgt += __popcll(__ballot(k > prefix)); }
    const int need = 256 - cgt; int eq_seen = 0, outc = 0;
    for (int j = 0; j < slots; ++j) { const int s = j * 64 + c.lane; const unsigned k = s <= q ? sel_key(row[s]) : 0u; const bool eq = k == prefix; const unsigned long long meq = __ballot(eq);
        const bool take = k > prefix || (eq && eq_seen + __popcll(meq & lt_mask) < need); const unsigned long long mt = __ballot(take);
        if (take) out[outc + __popcll(mt & lt_mask)] = s; outc += __popcll(mt); eq_seen += __popcll(meq); }
}
template <int NSL>
__device__ __forceinline__ void select_finish(const Ctx& c, LAS unsigned* lk, LAS unsigned short* li, int* out) {
    const unsigned long long lt_mask = (1ull << c.lane) - 1ull;
    unsigned kk[NSL];
#pragma unroll
    for (int i = 0; i < NSL; ++i) kk[i] = lk[i * 64 + c.lane];
    unsigned prefix = 0u;
#pragma nounroll
    for (int bit = 31; bit >= 0; --bit) { const unsigned cand = prefix | (1u << bit); int cnt = 0;
#pragma unroll
        for (int i = 0; i < NSL; ++i) cnt += __popcll(__ballot(kk[i] >= cand));
        if (cnt >= 256) prefix = cand;
        if (cnt == 256) break; }
    int cgt = 0, ceq = 0;
#pragma unroll
    for (int i = 0; i < NSL; ++i) { cgt += __popcll(__ballot(kk[i] > prefix)); ceq += __popcll(__ballot(kk[i] == prefix)); }
    const int need = 256 - cgt; int T = 0xffff;
    if (need < ceq) {
        int lo = 0, hi = NREAL - 1;
#pragma nounroll
        for (int it = 0; it < 13; ++it) { const int mid = (lo + hi) >> 1; int cn = 0;
#pragma unroll
            for (int i = 0; i < NSL; ++i) cn += __popcll(__ballot(kk[i] == prefix && (int)li[i * 64 + c.lane] <= mid));
            if (cn >= need) hi = mid; else lo = mid + 1; }
        T = lo;
    }
    int outc = 0;
#pragma unroll
    for (int i = 0; i < NSL; ++i) { const int s = li[i * 64 + c.lane]; const bool take = kk[i] > prefix || (kk[i] == prefix && s <= T); const unsigned long long mt = __ballot(take);
        if (take) out[outc + __popcll(mt & lt_mask)] = s;
        outc += __popcll(mt); }
}
__device__ __forceinline__ void phase_select_v3(const Params& p, const Ctx& c) {
    const float* SC = (const float*)(c.ws + WS_BIG + B_SC); int* IDX = (int*)(c.ws + WS_IDX);
    LAS unsigned* lk = (LAS unsigned*)c.lds + c.wave * (SEL_CAP + SEL_CAP / 2); LAS unsigned short* li = (LAS unsigned short*)(lk + SEL_CAP);
#ifndef SELDUP2
#define SELDUP2 1
#endif
#pragma nounroll
    for (int rep_ = 0; rep_ < SELDUP2; ++rep_)
    for (int q = c.b * NWAVES + c.wave; q < NREAL; q += c.G * NWAVES) {
        int* out = IDX + (size_t)q * 256;
        if (q < 256) {
#pragma unroll
            for (int j = 0; j < 4; ++j) { const int s = j * 64 + c.lane; out[s] = s <= q ? s : -1; }
            continue; }
        const float* row = SC + sc_off(q); const int slots = (q + 64) >> 6;
        unsigned tau0 = 0u;
        if (q + 1 > SEL_CAP) {
            const unsigned short* GM = (const unsigned short*)(c.ws + WS_GM) + (size_t)q * 1024; const int ng = (slots + 7) >> 3;
            unsigned gm[16];
#pragma unroll
            for (int i = 0; i < 16; ++i) gm[i] = i < ng ? (unsigned)GM[i * 64 + c.lane] : 0u;
#pragma nounroll
            for (int bit = 15; bit >= 0; --bit) { const unsigned cand = tau0 | (1u << bit); int cnt = 0;
#pragma unroll
                for (int i = 0; i < 16; ++i) cnt += __popcll(__ballot(gm[i] >= cand));
                if (cnt >= 256) tau0 = cand; }
            tau0 <<= 16;
        }
#pragma unroll
        for (int i = 0; i < 32; ++i) lk[i * 64 + c.lane] = 0u;
        int cntl = 0;
        const float tauf = tau0 == 0u ? -INFINITY : __uint_as_float((tau0 & 0x80000000u) ? (tau0 & 0x7fffffffu) : ~tau0);
#pragma nounroll
        for (int b4 = 0; b4 < 4; ++b4) if (b4 * 32 < slots) { float k[32];
#pragma unroll
            for (int i = 0; i < 32; ++i) { const int s = (b4 * 32 + i) * 64 + c.lane; k[i] = s <= q ? __builtin_nontemporal_load(row + s) : -INFINITY; }
#pragma unroll
            for (int i = 0; i < 32; ++i) { const int s = (b4 * 32 + i) * 64 + c.lane; const bool sv = tau0 == 0u ? s <= q : k[i] >= tauf;
                if (sv && cntl < 32) { lk[cntl * 64 + c.lane] = sel_key(k[i]); li[cntl * 64 + c.lane] = (unsigned short)s; }
                cntl += sv ? 1 : 0; } }
        LDS_WAIT();
        int mx = cntl;
#pragma unroll
        for (int o = 1; o < 64; o <<= 1) mx = max(mx, __shfl_xor(mx, o));
        mx = __builtin_amdgcn_readfirstlane(mx);
        if (mx > 32) select_row_slow(c, row, q, out);
        else if (mx <= 8) select_finish<8>(c, lk, li, out);
        else if (mx <= 16) select_finish<16>(c, lk, li, out);
        else select_finish<32>(c, lk, li, out);
        LDS_WAIT();
    }
}
__device__ __forceinline__ void phase_select_v2(const Params& p, const Ctx& c) {
    const float* SC = (const float*)(c.ws + WS_BIG + B_SC); int* IDX = (int*)(c.ws + WS_IDX);
    for (int gi = c.b; gi < NREAL / 4; gi += c.G) {
        const int q0 = gi * 4;
        if (q0 < 256) { const int q = q0 + (c.wave >> 1), s0 = (c.wave & 1) * 128; int* out = IDX + (size_t)q * 256;
            out[s0 + c.lane] = (s0 + c.lane) <= q ? s0 + c.lane : -1; out[s0 + 64 + c.lane] = (s0 + 64 + c.lane) <= q ? s0 + 64 + c.lane : -1; continue; }
        if (q0 + 3 < 2048) select_group<16>(c, SC, IDX, q0);
        else if (q0 + 3 < 4096) select_group<32>(c, SC, IDX, q0);
        else select_group<64>(c, SC, IDX, q0);
    }
}
__device__ __forceinline__ void phase_qlat(const Params& p, const Ctx& c) {
    const bf16_t* proj = (const bf16_t*)(c.ws + WS_BIG + B_PROJ); bf16_t* QL = (bf16_t*)(c.ws + WS_QL); const float* wuk = p.in[I_WUK];
    LAS float* sq = (LAS float*)c.lds;
    const int sub = c.tid >> 8, r = c.tid & 255; constexpr int NT32 = (NTOK + 31) / 32;
    for (int it = c.b; it < NT32 * 8; it += c.G) {
        const int tile = it >> 3, h = it & 7, r0 = tile * 32;
        __syncthreads();
        for (int i = c.tid; i < 32 * 16; i += NTHR) { const int rr = i >> 4, c8 = (i & 15) * 8; const int row = r0 + rr;
            u32x4 v = (u32x4){0u, 0u, 0u, 0u}; if (row < NTOK) v = *(const u32x4*)(proj + (size_t)row * N_CDP + 2048 + h * 128 + c8);
            LAS float* d = sq + rr * 128 + c8; d[0] = bflo(v.x); d[1] = bfhi(v.x); d[2] = bflo(v.y); d[3] = bfhi(v.y); d[4] = bflo(v.z); d[5] = bfhi(v.z); d[6] = bflo(v.w); d[7] = bfhi(v.w); }
        __syncthreads();
        float acc[16];
#pragma unroll
        for (int k = 0; k < 16; ++k) acc[k] = 0.f;
        const float* w = wuk + (size_t)r * 1024 + h * 128;
        for (int d = 0; d < 128; d += 4) { const f32x4 wv = *(const f32x4*)(w + d);
#pragma unroll
            for (int k = 0; k < 16; ++k) { const f32x4 qv = *(const LAS f32x4*)(sq + (sub * 16 + k) * 128 + d); acc[k] += qv[0] * wv[0] + qv[1] * wv[1] + qv[2] * wv[2] + qv[3] * wv[3]; } }
#pragma unroll
        for (int k = 0; k < 16; ++k) { const int row = r0 + sub * 16 + k; if (row < NTOK) QL[(size_t)row * DM + h * 256 + r] = (bf16_t)f2bf(acc[k] * 0.08838834764831845f); }
    }
}
__device__ __forceinline__ void phase_attn_simple(const Params& p, const Ctx& c) {
    const bf16_t* QL = (const bf16_t*)(c.ws + WS_QL); bf16_t* OL = (bf16_t*)(c.ws + WS_BIG + B_OL); const bf16_t* C = (const bf16_t*)(c.ws + WS_C); const int* IDX = (const int*)(c.ws + WS_IDX);
    LAS float* sq = (LAS float*)c.lds + c.wave * 256;
    for (int it = c.b * NWAVES + c.wave; it < NTOK * 8; it += c.G * NWAVES) {
        const int row = it >> 3, h = it & 7;
        { const u32x2 v = *(const u32x2*)(QL + (size_t)row * DM + h * 256 + 4 * c.lane); *(LAS f32x4*)(sq + 4 * c.lane) = (f32x4){bflo(v.x), bfhi(v.x), bflo(v.y), bfhi(v.y)}; }
        LDS_WAIT();
        float s[5]; int kr[5];
#pragma unroll
        for (int r5 = 0; r5 < 5; ++r5) {
            const int j = r5 * 64 + c.lane; bool valid = false; int k = 0;
            if (row >= NREAL) { valid = j <= row - NREAL; k = NREAL + j; }
            else if (j < 16) { valid = true; k = NREAL + j; }
            else if (j < 272) { k = IDX[(size_t)row * 256 + j - 16]; valid = k >= 0; }
            float d = 0.f;
            if (valid) { const u32x4* cr = (const u32x4*)(C + (size_t)k * 256);
#pragma unroll 4
                for (int d8 = 0; d8 < 32; ++d8) { const u32x4 cv = cr[d8]; const f32x4 q0 = *(const LAS f32x4*)(sq + d8 * 8), q1 = *(const LAS f32x4*)(sq + d8 * 8 + 4);
                    d += q0[0] * bflo(cv.x) + q0[1] * bfhi(cv.x) + q0[2] * bflo(cv.y) + q0[3] * bfhi(cv.y) + q1[0] * bflo(cv.z) + q1[1] * bfhi(cv.z) + q1[2] * bflo(cv.w) + q1[3] * bfhi(cv.w); } }
            s[r5] = valid ? d : -INFINITY; kr[r5] = valid ? k : 0;
        }
        float m = fmaxf(fmaxf(fmaxf(s[0], s[1]), fmaxf(s[2], s[3])), s[4]); m = wave_max(m);
        float e[5], sum = 0.f;
#pragma unroll
        for (int r5 = 0; r5 < 5; ++r5) { e[r5] = s[r5] == -INFINITY ? 0.f : __expf(s[r5] - m); sum += e[r5]; }
        const float inv = 1.0f / wave_sum(sum);
        float o0 = 0.f, o1 = 0.f, o2 = 0.f, o3 = 0.f;
#pragma unroll
        for (int r5 = 0; r5 < 5; ++r5) {
            const float pr = e[r5] * inv; const int nl = r5 == 4 ? 16 : 64;
            for (int l = 0; l < nl; ++l) {
                const float pj = __int_as_float(__builtin_amdgcn_readlane(__float_as_int(pr), l));
                if (pj != 0.f) { const int k = __builtin_amdgcn_readlane(kr[r5], l); const u32x2 cv = *(const u32x2*)(C + (size_t)k * 256 + 4 * c.lane);
                    o0 += pj * bflo(cv.x); o1 += pj * bfhi(cv.x); o2 += pj * bflo(cv.y); o3 += pj * bfhi(cv.y); }
            }
        }
        *(u32x2*)(OL + (size_t)row * DM + h * 256 + 4 * c.lane) = (u32x2){pk2(o0, o1), pk2(o2, o3)};
        LDS_WAIT();
    }
}
__device__ __forceinline__ void phase_attn_fast(const Params& p, const Ctx& c) {
    const bf16_t* QL = (const bf16_t*)(c.ws + WS_QL); bf16_t* OL = (bf16_t*)(c.ws + WS_BIG + B_OL); const bf16_t* C = (const bf16_t*)(c.ws + WS_C); const int* IDX = (const int*)(c.ws + WS_IDX);
    LAS float* sp = (LAS float*)c.lds + c.wave * (272 * 8 + 272);
    LAS int* sk = (LAS int*)(sp + 272 * 8);
    const int n = c.lane & 15, g = c.lane >> 4;
    for (int row = c.b * NWAVES + c.wave; row < NTOK; row += c.G * NWAVES) {
        const bool meta = row >= NREAL; const int nt = meta ? 1 : 17;
        bf16x8 a[8];
#pragma unroll
        for (int s = 0; s < 8; ++s) { a[s] = (bf16x8){0, 0, 0, 0, 0, 0, 0, 0}; if (n < 8) a[s] = *(const bf16x8*)(QL + (size_t)row * DM + n * 256 + 32 * s + 8 * g); }
        f32x4 sc[17]; float mx[4] = {-INFINITY, -INFINITY, -INFINITY, -INFINITY};
#pragma unroll
        for (int t = 0; t < 17; ++t) {
            sc[t] = (f32x4){-INFINITY, -INFINITY, -INFINITY, -INFINITY};
            if (t < nt) {
                int k; bool valid;
                if (t == 0) { k = NREAL + n; valid = meta ? (n <= row - NREAL) : true; }
                else { k = IDX[(size_t)row * 256 + 16 * (t - 1) + n]; valid = k >= 0; k = valid ? k : 0; }
                if (g == 0) sk[16 * t + n] = k;
                f32x4 acc = (f32x4){0.f, 0.f, 0.f, 0.f}; const bf16_t* cr = C + (size_t)k * 256 + 8 * g;
#pragma unroll
                for (int s = 0; s < 8; ++s) { const bf16x8 b = *(const bf16x8*)(cr + 32 * s); acc = __builtin_amdgcn_mfma_f32_16x16x32_bf16(a[s], b, acc, 0, 0, 0); }
                if (valid) sc[t] = acc;
#pragma unroll
                for (int r = 0; r < 4; ++r) mx[r] = fmaxf(mx[r], sc[t][r]);
            }
        }
#pragma unroll
        for (int r = 0; r < 4; ++r) mx[r] = row16_max(mx[r]);
        float sm[4] = {0.f, 0.f, 0.f, 0.f};
#pragma unroll
        for (int t = 0; t < 17; ++t) if (t < nt) {
#pragma unroll
            for (int r = 0; r < 4; ++r) { const float e = sc[t][r] == -INFINITY ? 0.f : __expf(sc[t][r] - mx[r]); sc[t][r] = e; sm[r] += e; } }
#pragma unroll
        for (int r = 0; r < 4; ++r) sm[r] = 1.0f / row16_sum(sm[r]);
#pragma unroll
        for (int t = 0; t < 17; ++t) if (t < nt && g < 2) *(LAS f32x4*)(sp + (16 * t + n) * 8 + 4 * g) = (f32x4){sc[t][0] * sm[0], sc[t][1] * sm[1], sc[t][2] * sm[2], sc[t][3] * sm[3]};
        LDS_WAIT();
        f32x4 o[8];
#pragma unroll
        for (int h = 0; h < 8; ++h) o[h] = (f32x4){0.f, 0.f, 0.f, 0.f};
        for (int t = 0; t < nt; ++t) {
            u32x2 cv[16];
#pragma unroll
            for (int nn = 0; nn < 16; ++nn) { const int k = __builtin_amdgcn_readfirstlane(sk[16 * t + nn]); cv[nn] = *(const u32x2*)(C + (size_t)k * 256 + 4 * c.lane); }
#pragma unroll
            for (int nn = 0; nn < 16; ++nn) { const f32x4 p0 = *(const LAS f32x4*)(sp + (16 * t + nn) * 8), p1 = *(const LAS f32x4*)(sp + (16 * t + nn) * 8 + 4);
                const f32x4 cf = (f32x4){bflo(cv[nn].x), bfhi(cv[nn].x), bflo(cv[nn].y), bfhi(cv[nn].y)};
                o[0] += p0[0] * cf; o[1] += p0[1] * cf; o[2] += p0[2] * cf; o[3] += p0[3] * cf; o[4] += p1[0] * cf; o[5] += p1[1] * cf; o[6] += p1[2] * cf; o[7] += p1[3] * cf; }
        }
#pragma unroll
        for (int h = 0; h < 8; ++h) *(u32x2*)(OL + (size_t)row * DM + h * 256 + 4 * c.lane) = (u32x2){pk2(o[h][0], o[h][1]), pk2(o[h][2], o[h][3])};
        LDS_WAIT();
    }
}
__device__ __forceinline__ unsigned att_off_b(unsigned row, unsigned ch) { return 256u * row + 16u * (ch ^ (((row & 3u) << 2) | ((row >> 2) & 3u))); }
__device__ __forceinline__ u32x2 tr_issue(unsigned addr) { u32x2 r; asm volatile("ds_read_b64_tr_b16 %0, %1" : "=v"(r) : "v"(addr) : "memory"); return r; }
__device__ __forceinline__ u32x2 tr_issue_h1(unsigned addr) { u32x2 r; asm volatile("ds_read_b64_tr_b16 %0, %1 offset:4096" : "=v"(r) : "v"(addr) : "memory"); return r; }
__device__ __forceinline__ void phase_attn_flash(const Params& p, const Ctx& c) {
    const bf16_t* QL = (const bf16_t*)(c.ws + WS_QL); bf16_t* OL = (bf16_t*)(c.ws + WS_BIG + B_OL); const bf16_t* C = (const bf16_t*)(c.ws + WS_C); const int* IDX = (const int*)(c.ws + WS_IDX);
    constexpr int WB = 8192 + 512 + 256 + 1024;
    LAS unsigned char* img = c.lds + c.wave * WB; LAS int* ix = (LAS int*)(img + 8192 + 512 + 256);
    const unsigned img_a = (unsigned)(size_t)img;
    const int n = c.lane & 15, g = c.lane >> 4, q4 = n >> 2, p4 = n & 3;
    unsigned wr_a[4];
#pragma unroll
    for (int s = 0; s < 4; ++s) wr_a[s] = att_off_b(n, (4 * s + g) & 15);
    const unsigned rw = 4 * g + q4, rd_z = ((rw & 3u) << 2) | ((rw >> 2) & 3u), rd_b = img_a + 256u * rw + 8 * (p4 & 1);
#ifndef ATTNDUP
#define ATTNDUP 1
#endif
#pragma nounroll
    for (int rep_ = 0; rep_ < ATTNDUP; ++rep_)
    for (int row = c.b * NWAVES + c.wave; row < NTOK; row += c.G * NWAVES) {
        const bool meta = row >= NREAL; const int nt = meta ? 1 : 17;
        if (!meta) {
#pragma unroll
            for (int j = 0; j < 4; ++j) ix[64 * j + c.lane] = IDX[(size_t)row * 256 + 64 * j + c.lane]; }
        bf16x8 a[8];
#pragma unroll
        for (int s = 0; s < 8; ++s) { a[s] = (bf16x8){0, 0, 0, 0, 0, 0, 0, 0}; if (n < 8) a[s] = *(const bf16x8*)(QL + (size_t)row * DM + n * 256 + 32 * s + 8 * g); }
        LDS_WAIT();
        f32x4 O[16];
#pragma unroll
        for (int cc = 0; cc < 16; ++cc) O[cc] = (f32x4){0.f, 0.f, 0.f, 0.f};
        float mrun = -INFINITY, lrun = 0.f;
        int k = NREAL + n; bool valid = meta ? (n <= row - NREAL) : true;
        bf16x8 b[8];
        { const bf16_t* cr = C + (size_t)k * 256 + 8 * g;
#pragma unroll
          for (int s = 0; s < 8; ++s) b[s] = *(const bf16x8*)(cr + 32 * s); }
#pragma nounroll
        for (int t = 0; t < nt; ++t) {
            int kn = 0; bool validn = false; bf16x8 bn[8];
            if (t + 1 < nt) { kn = ix[16 * t + n]; validn = kn >= 0; kn = validn ? kn : 0; const bf16_t* cr = C + (size_t)kn * 256 + 8 * g;
#pragma unroll
                for (int s = 0; s < 8; ++s) bn[s] = *(const bf16x8*)(cr + 32 * s); }
            else {
#pragma unroll
                for (int s = 0; s < 8; ++s) bn[s] = b[s]; }
            f32x4 sc = (f32x4){0.f, 0.f, 0.f, 0.f};
#pragma unroll
            for (int s = 0; s < 8; ++s) sc = __builtin_amdgcn_mfma_f32_16x16x32_bf16(b[s], a[s], sc, 0, 0, 0);
#pragma unroll
            for (int s = 0; s < 8; ++s) *(LAS bf16x8*)(img + (s >> 2) * 4096 + wr_a[s & 3]) = b[s];
            u32x2 v[8];
#pragma unroll
            for (int j = 0; j < 8; ++j) v[j] = tr_issue(rd_b + 16u * ((unsigned)(2 * j + (p4 >> 1)) ^ rd_z));
            const unsigned vm = (unsigned)__ballot(valid) & 0xffffu;
            float x0 = sc[0], x1 = sc[1], x2 = sc[2], x3 = sc[3];
            if (vm != 0xffffu) { const unsigned mb = vm >> (4 * g); x0 = (mb & 1u) ? x0 : -INFINITY; x1 = (mb & 2u) ? x1 : -INFINITY; x2 = (mb & 4u) ? x2 : -INFINITY; x3 = (mb & 8u) ? x3 : -INFINITY; }
            const float mn = fmaxf(mrun, xrow16_max(fmaxf(fmaxf(x0, x1), fmaxf(x2, x3))));
            const float alpha = __expf(mrun - mn);
            const float e0 = __expf(x0 - mn), e1 = __expf(x1 - mn), e2 = __expf(x2 - mn), e3 = __expf(x3 - mn);
            lrun = lrun * alpha + xrow16_sum((e0 + e1) + (e2 + e3)); mrun = mn;
            const bf16x8 pb = __builtin_bit_cast(bf16x8, (u32x4){pk2(e0, e1), pk2(e2, e3), 0u, 0u});
            if (__ballot(alpha != 1.0f) != 0ull) {
#pragma unroll
                for (int cc = 0; cc < 16; ++cc) O[cc] = O[cc] * alpha; }
            asm volatile("s_waitcnt lgkmcnt(0)" : "+v"(v[0]), "+v"(v[1]), "+v"(v[2]), "+v"(v[3]), "+v"(v[4]), "+v"(v[5]), "+v"(v[6]), "+v"(v[7]) :: "memory");
#pragma unroll
            for (int j = 0; j < 8; ++j) { const u32x4 au = (u32x4){v[j].x, v[j].y, v[j].x, v[j].y};
                O[j] = __builtin_amdgcn_mfma_f32_16x16x32_bf16(__builtin_bit_cast(bf16x8, au), pb, O[j], 0, 0, 0); }
#pragma unroll
            for (int j = 0; j < 8; ++j) v[j] = tr_issue(rd_b + 4096u + 16u * ((unsigned)(2 * j + (p4 >> 1)) ^ rd_z));
            asm volatile("s_waitcnt lgkmcnt(0)" : "+v"(v[0]), "+v"(v[1]), "+v"(v[2]), "+v"(v[3]), "+v"(v[4]), "+v"(v[5]), "+v"(v[6]), "+v"(v[7]) :: "memory");
#pragma unroll
            for (int j = 0; j < 8; ++j) { const u32x4 au = (u32x4){v[j].x, v[j].y, v[j].x, v[j].y};
                O[8 + j] = __builtin_amdgcn_mfma_f32_16x16x32_bf16(__builtin_bit_cast(bf16x8, au), pb, O[8 + j], 0, 0, 0); }
#pragma unroll
            for (int s = 0; s < 8; ++s) b[s] = bn[s];
            k = kn; valid = validn;
        }
        if (n < 8) { const float inv = 1.0f / lrun;
#pragma unroll
            for (int cc = 0; cc < 16; ++cc) *(LAS u32x2*)(img + (n * 256 + 16 * cc + 4 * g) * 2) = (u32x2){pk2(O[cc][0] * inv, O[cc][1] * inv), pk2(O[cc][2] * inv, O[cc][3] * inv)}; }
        LDS_WAIT();
#pragma unroll
        for (int i = 0; i < 4; ++i) { const u32x4 v = *(const LAS u32x4*)(img + (i * 64 + c.lane) * 16); *(u32x4*)(OL + (size_t)row * DM + (i * 64 + c.lane) * 8) = v; }
        LDS_WAIT();
    }
}
__device__ __forceinline__ void phase_attproj(const Params& p, const Ctx& c) {
    const bf16_t* OL = (const bf16_t*)(c.ws + WS_BIG + B_OL); bf16_t* MO = (bf16_t*)(c.ws + WS_HN); const float* wuv = p.in[I_WUV];
    LAS float* so = (LAS float*)c.lds;
    const int sub = c.tid >> 7, d = c.tid & 127; constexpr int NT32 = (NTOK + 31) / 32;
    for (int it = c.b; it < NT32 * 8; it += c.G) {
        const int tile = it >> 3, h = it & 7, r0 = tile * 32;
        __syncthreads();
        for (int i = c.tid; i < 32 * 32; i += NTHR) { const int rr = i >> 5, c8 = (i & 31) * 8; const int row = r0 + rr;
            u32x4 v = (u32x4){0u, 0u, 0u, 0u}; if (row < NTOK) v = *(const u32x4*)(OL + (size_t)row * DM + h * 256 + c8);
            LAS float* dd = so + rr * 256 + c8; dd[0] = bflo(v.x); dd[1] = bfhi(v.x); dd[2] = bflo(v.y); dd[3] = bfhi(v.y); dd[4] = bflo(v.z); dd[5] = bfhi(v.z); dd[6] = bflo(v.w); dd[7] = bfhi(v.w); }
        __syncthreads();
        float acc[8];
#pragma unroll
        for (int k = 0; k < 8; ++k) acc[k] = 0.f;
        const float* w = wuv + h * 128 + d;
        for (int r = 0; r < 256; r += 4) { float wv[4];
#pragma unroll
            for (int j = 0; j < 4; ++j) wv[j] = w[(size_t)(r + j) * 1024];
#pragma unroll
            for (int k = 0; k < 8; ++k) { const f32x4 ov = *(const LAS f32x4*)(so + (sub * 8 + k) * 256 + r); acc[k] += ov[0] * wv[0] + ov[1] * wv[1] + ov[2] * wv[2] + ov[3] * wv[3]; } }
#pragma unroll
        for (int k = 0; k < 8; ++k) { const int row = r0 + sub * 8 + k; if (row < NTOK) MO[(size_t)row * DM + 1024 + h * 128 + d] = (bf16_t)f2bf(acc[k]); }
    }
}

#ifdef CHECKS
__device__ __forceinline__ void chk_gemm(const Ctx& c, const bf16_t* A, int lda, int K, const float* W, int ldw, int ncols, const void* out, int ldo, bool out_bf16, unsigned bit) {
    const int gid = c.b * NTHR + c.tid; if (gid >= 4096) return;
    const unsigned h = (unsigned)gid * 2654435761u; const int row = (int)((h >> 8) % NTOK); const int n = (int)(((h * 40503u) >> 4) % (unsigned)ncols);
    float acc = 0.f; for (int k = 0; k < K; ++k) acc += bf2f(A[(size_t)row * lda + k]) * W[(size_t)k * ldw + n];
    const float got = out_bf16 ? bf2f(((const bf16_t*)out)[(size_t)row * ldo + n]) : ((const float*)out)[(size_t)row * ldo + n];
    if (!(fabsf(got - acc) <= 0.03f * fabsf(acc) + 0.05f)) atomicOr((unsigned*)(c.ws + WS_CTL), bit);
}
__device__ __forceinline__ void chk_swiglu(const Ctx& c, const bf16_t* A, const float* W1, const float* W3, const bf16_t* act, unsigned bit) {
    const int gid = c.b * NTHR + c.tid; if (gid >= 4096) return;
    const unsigned h = (unsigned)gid * 2654435761u; const int row = (int)((h >> 8) % NTOK); const int n = (int)(((h * 40503u) >> 4) % (unsigned)DFF);
    float a = 0.f, b = 0.f; for (int k = 0; k < DM; ++k) { const float x = bf2f(A[(size_t)row * DM + k]); a += x * W1[(size_t)k * DFF + n]; b += x * W3[(size_t)k * DFF + n]; }
    const float ref = siluf_(a) * b, got = bf2f(act[(size_t)row * DFF + n]);
    if (!(fabsf(got - ref) <= 0.03f * fabsf(ref) + 0.05f)) atomicOr((unsigned*)(c.ws + WS_CTL), bit);
}
#ifndef RG_TMAX
#define RG_TMAX 300
#endif
__device__ __forceinline__ void chk_rg(const Params& p, const Ctx& c, unsigned bit) {
    const int gid = c.b * NTHR + c.tid; if (gid >= (RG_TMAX > 300 ? 1024 : 4096)) return;
    const bf16_t* proj = (const bf16_t*)(c.ws + WS_BIG + B_PROJ); const bf16_t* MO = (const bf16_t*)(c.ws + WS_HN);
    const unsigned h = (unsigned)gid * 2654435761u; const int t = (int)((h >> 8) % (unsigned)RG_TMAX); const int ch = (int)(((h * 40503u) >> 4) % 1024u); const int n = ch >> 7, d = ch & 127;
    const float* wa = p.in[I_RG_WA] + (size_t)n * 16384 + d; const float* wi = p.in[I_RG_WI] + (size_t)n * 16384 + d;
    const float sp = logf(1.0f + expf(-p.in[I_RG_LAM][ch]));
    float hs = 0.f;
    for (int s = 0; s <= t; ++s) {
        float ga = p.in[I_RG_BA][ch], gi = p.in[I_RG_BI][ch], ud = 0.f;
        for (int cc = 0; cc < 128; ++cc) { const int chn = n * 128 + cc; float u = p.in[I_RG_CB][chn];
            for (int j = 0; j < 4; ++j) { const int tp = s - 3 + j; if (tp >= 0) u += p.in[I_RG_CW][j * 1024 + chn] * bf2f(proj[(size_t)row_of(tp) * N_CDP + chn]); }
            ga += u * wa[cc * 128]; gi += u * wi[cc * 128]; if (cc == d) ud = u; }
        const float r = 1.0f / (1.0f + expf(-ga)), ig = 1.0f / (1.0f + expf(-gi)), la = -8.0f * r * sp, a = expf(la);
        hs = a * hs + sqrtf(1.0f - expf(2.0f * la)) * ig * ud;
    }
    const float ref = hs * gelu_tanh(bf2f(proj[(size_t)row_of(t) * N_CDP + 1024 + ch])), got = bf2f(MO[(size_t)row_of(t) * DM + ch]);
    if (!(fabsf(got - ref) <= 0.03f * fabsf(ref) + 0.01f)) atomicOr((unsigned*)(c.ws + WS_CTL), bit);
}
__device__ __forceinline__ void chk_fire(const Ctx& c, unsigned bit) { atomicOr((unsigned*)(c.ws + WS_CTL), bit); }
__device__ __forceinline__ void chk_scores(const Params& p, const Ctx& c, unsigned bit) {
    const int gid = c.b * NTHR + c.tid; if (gid >= 8192) return;
    const bf16_t* proj = (const bf16_t*)(c.ws + WS_BIG + B_PROJ); const float* SC = (const float*)(c.ws + WS_BIG + B_SC);
    const unsigned h = (unsigned)gid * 2654435761u; const int q = (int)((h >> 8) % NREAL); const int s = (int)(((h * 40503u) >> 4) % (unsigned)(q + 1));
    float sc = 0.f;
    for (int hh = 0; hh < 16; ++hh) { float d = 0.f; for (int k = 0; k < 64; ++k) d += bf2f(proj[(size_t)q * N_CDP + 3328 + hh * 64 + k]) * bf2f(proj[(size_t)s * N_CDP + 4352 + k]);
        sc += fmaxf(d * 0.125f, 0.f) * bf2f(proj[(size_t)q * N_CDP + 4416 + hh]) * 0.25f; }
    const float got = SC[sc_off(q) + s];
    if (!(fabsf(got - sc) <= 1e-3f * fabsf(sc) + 1e-3f)) chk_fire(c, bit);
}
__device__ __forceinline__ void chk_select(const Params& p, const Ctx& c, unsigned bit) {
    const int gid = c.b * NTHR + c.tid; if (gid >= 2048) return;
    const float* SC = (const float*)(c.ws + WS_BIG + B_SC); const int* IDX = (const int*)(c.ws + WS_IDX);
    const unsigned h = (unsigned)gid * 2654435761u; const int q = (int)((h >> 8) % NREAL); const float* row = SC + sc_off(q); const int* id = IDX + (size_t)q * 256;
    bool bad = false;
    if (q < 256) { int nv = 0; for (int j = 0; j < 256; ++j) { const int e = id[j]; if (e >= 0) { ++nv; if (e > q) bad = true; } } if (nv != q + 1) bad = true;
        for (int j = 0; j < 256; ++j) for (int k = j + 1; k < 256; ++k) if (id[j] >= 0 && id[j] == id[k]) bad = true; }
    else { float m = INFINITY; for (int j = 0; j < 256; ++j) { const int e = id[j]; if (e < 0 || e > q) { bad = true; break; } m = fminf(m, row[e]); }
        if (!bad) { int gt = 0, ge = 0; for (int s = 0; s <= q; ++s) { gt += row[s] > m; ge += row[s] >= m; } if (gt >= 256 || ge < 256) bad = true;
            for (int j = 0; j < 256; ++j) for (int k = j + 1; k < 256; ++k) if (id[j] == id[k]) bad = true; } }
    if (bad) chk_fire(c, bit);
}
__device__ __forceinline__ void chk_qlat(const Params& p, const Ctx& c, unsigned bit) {
    const int gid = c.b * NTHR + c.tid; if (gid >= 8192) return;
    const bf16_t* proj = (const bf16_t*)(c.ws + WS_BIG + B_PROJ); const bf16_t* QL = (const bf16_t*)(c.ws + WS_QL);
    const unsigned h = (unsigned)gid * 2654435761u; const int row = (int)((h >> 8) % NTOK); const int col = (int)(((h * 40503u) >> 4) % 2048u); const int hh = col >> 8, r = col & 255;
    float a = 0.f; for (int d = 0; d < 128; ++d) a += bf2f(proj[(size_t)row * N_CDP + 2048 + hh * 128 + d]) * p.in[I_WUK][(size_t)r * 1024 + hh * 128 + d];
    a *= 0.08838834764831845f; const float got = bf2f(QL[(size_t)row * DM + col]);
    if (!(fabsf(got - a) <= 0.02f * fabsf(a) + 2e-3f)) chk_fire(c, bit);
}
__device__ __forceinline__ void chk_attn(const Params& p, const Ctx& c, unsigned bit) {
    const int gid = c.b * NTHR + c.tid; if (gid >= 2048) return;
    const bf16_t* QL = (const bf16_t*)(c.ws + WS_QL); const bf16_t* OL = (const bf16_t*)(c.ws + WS_BIG + B_OL); const bf16_t* C = (const bf16_t*)(c.ws + WS_C); const int* IDX = (const int*)(c.ws + WS_IDX);
    const unsigned h = (unsigned)gid * 2654435761u; const int row = gid < 64 ? NREAL + (gid & 15) : (int)((h >> 8) % NREAL); const int col = (int)(((h * 40503u) >> 4) % 2048u); const int hh = col >> 8, r = col & 255;
    float m = -INFINITY;
    for (int pass = 0; pass < 2; ++pass) { float sum = 0.f, o = 0.f;
        for (int j = 0; j < 272; ++j) { int k; bool valid;
            if (row >= NREAL) { valid = j <= row - NREAL; k = NREAL + j; } else if (j < 16) { valid = true; k = NREAL + j; } else { k = IDX[(size_t)row * 256 + j - 16]; valid = k >= 0; }
            if (!valid) continue;
            float s = 0.f; for (int d = 0; d < 256; ++d) s += bf2f(QL[(size_t)row * DM + hh * 256 + d]) * bf2f(C[(size_t)k * 256 + d]);
            if (pass == 0) m = fmaxf(m, s); else { const float e = expf(s - m); sum += e; o += e * bf2f(C[(size_t)k * 256 + r]); } }
        if (pass == 1) { const float ref = o / sum, got = bf2f(OL[(size_t)row * DM + col]); if (!(fabsf(got - ref) <= 0.03f * fabsf(ref) + 5e-3f)) chk_fire(c, bit); } }
}
__device__ __forceinline__ void chk_attproj(const Params& p, const Ctx& c, unsigned bit) {
    const int gid = c.b * NTHR + c.tid; if (gid >= 8192) return;
    const bf16_t* OL = (const bf16_t*)(c.ws + WS_BIG + B_OL); const bf16_t* MO = (const bf16_t*)(c.ws + WS_HN);
    const unsigned h = (unsigned)gid * 2654435761u; const int row = (int)((h >> 8) % NTOK); const int col = (int)(((h * 40503u) >> 4) % 1024u); const int hh = col >> 7, d = col & 127;
    float a = 0.f; for (int r = 0; r < 256; ++r) a += bf2f(OL[(size_t)row * DM + hh * 256 + r]) * p.in[I_WUV][(size_t)r * 1024 + hh * 128 + d];
    const float got = bf2f(MO[(size_t)row * DM + 1024 + col]);
    if (!(fabsf(got - a) <= 0.02f * fabsf(a) + 5e-3f)) chk_fire(c, bit);
}
__device__ __forceinline__ void chk_c(const Params& p, const Ctx& c, unsigned bit) {
    const int gid = c.b * NTHR + c.tid; if (gid >= 8192) return;
    const bf16_t* proj = (const bf16_t*)(c.ws + WS_BIG + B_PROJ); const bf16_t* C = (const bf16_t*)(c.ws + WS_C);
    const unsigned h = (unsigned)gid * 2654435761u; const int row = (int)((h >> 8) % NTOK); const int r = (int)(((h * 40503u) >> 4) % 256u);
    float ss = 0.f; for (int d = 0; d < 256; ++d) { const float v = bf2f(proj[(size_t)row * N_CDP + 3072 + d]); ss += v * v; }
    const float ref = bf2f(proj[(size_t)row * N_CDP + 3072 + r]) / sqrtf(ss / 256.0f + EPS) * p.in[I_KVN][r], got = bf2f(C[(size_t)row * 256 + r]);
    if (!(fabsf(got - ref) <= 0.02f * fabsf(ref) + 5e-3f)) chk_fire(c, bit);
}
#define CHK(x) x
#else
#define CHK(x)
#endif
template <int MODE>
__device__ __forceinline__ void meta_gemm(const Ctx& c, const bf16_t* A, int K, const bf16_t* Bt, int N, void* out, int ldo, int nmain, const float* rs) {
    LAS f32x4* red = (LAS f32x4*)c.lds;
    const int n = c.lane & 15, g = c.lane >> 4, t2 = c.wave >> 2, ks = c.wave & 3, kq = K / 4;
    const int nitems = (MODE == 2 ? N / 2 : N) / 32;
    const int rem = nmain % c.G, nlight = rem == 0 ? c.G : c.G - rem;
    const int myl = c.G - 1 - c.b; if (myl >= nlight) return;
    const bf16_t* ap = A + (size_t)(NREAL + n) * K + ks * kq + 8 * g;
    for (int it = myl; it < nitems; it += nlight) {
        const int ot = 2 * it + t2;
        const int brow = MODE == 2 ? (ot >> 3) * 256 + (ot & 7) * 16 : ot * 16;
        const bf16_t* bp = Bt + (size_t)(brow + n) * K + ks * kq + 8 * g;
        f32x4 acc = (f32x4){0.f, 0.f, 0.f, 0.f}, acc2 = (f32x4){0.f, 0.f, 0.f, 0.f};
#pragma unroll 4
        for (int s = 0; s < kq / 32; ++s) { const bf16x8 a = *(const bf16x8*)(ap + 32 * s); const bf16x8 b = *(const bf16x8*)(bp + 32 * s);
            acc = __builtin_amdgcn_mfma_f32_16x16x32_bf16(b, a, acc, 0, 0, 0);
            if (MODE == 2) { const bf16x8 b2 = *(const bf16x8*)(bp + (size_t)128 * K + 32 * s); acc2 = __builtin_amdgcn_mfma_f32_16x16x32_bf16(b2, a, acc2, 0, 0, 0); } }
        red[c.wave * 64 + c.lane] = acc; if (MODE == 2) red[512 + c.wave * 64 + c.lane] = acc2;
        __syncthreads();
        if (ks == 0) {
            const float rsc = rs ? rs[NREAL + n] : 1.0f;
            f32x4 v = (red[c.wave * 64 + c.lane] + red[(c.wave + 1) * 64 + c.lane] + red[(c.wave + 2) * 64 + c.lane] + red[(c.wave + 3) * 64 + c.lane]) * rsc;
            const size_t o = (size_t)(NREAL + n) * ldo + 16 * ot + 4 * g;
            if (MODE == 0) *(u32x2*)((bf16_t*)out + o) = (u32x2){pk2(v[0], v[1]), pk2(v[2], v[3])};
            if (MODE == 1) *(f32x4*)((float*)out + o) = v;
            if (MODE == 2) { const f32x4 u = (red[512 + c.wave * 64 + c.lane] + red[512 + (c.wave + 1) * 64 + c.lane] + red[512 + (c.wave + 2) * 64 + c.lane] + red[512 + (c.wave + 3) * 64 + c.lane]) * rsc;
                *(u32x2*)((bf16_t*)out + o) = (u32x2){pk2(siluf_(v[0]) * u[0], siluf_(v[1]) * u[1]), pk2(siluf_(v[2]) * u[2], siluf_(v[3]) * u[3])}; }
        }
        __syncthreads();
    }
}
__device__ __forceinline__ void convert_fill(const Params& p, const Ctx& c, int layer, int part, int nmain) {
    const int rem = nmain % c.G, nlight = rem == 0 ? c.G : c.G - rem; const int myl = c.G - 1 - c.b; if (myl >= nlight) return;
    phase_convert(p, c, layer, part, myl * NWAVES + c.wave, nlight * NWAVES);
}
constexpr int LDS_BYTES = 147456;
constexpr int NPHASE = 23;
__global__ void __launch_bounds__(NTHR, 2) mega(Params p, int ph_lo, int ph_hi) {
    extern __shared__ __attribute__((aligned(16))) unsigned char lds_raw[];
    cg::grid_group grid = cg::this_grid();
    { volatile LAS unsigned* misc_ = (volatile LAS unsigned*)((LAS unsigned char*)lds_raw + 147456 - 256); if (threadIdx.x < 16) misc_[threadIdx.x] = 0u; }
    __syncthreads();
    XcdBarrier xbar = xcd_barrier_post((unsigned*)(p.ws + WS_CTL + 4096), (volatile LAS unsigned*)((LAS unsigned char*)lds_raw + 147456 - 256));
    Ctx c; c.lds = (LAS unsigned char*)lds_raw; c.ws = p.ws; c.tid = threadIdx.x; c.lane = c.tid & 63; c.wave = __builtin_amdgcn_readfirstlane(c.tid >> 6); c.G = gridDim.x; c.b = blockIdx.x;
    const bf16_t* Tin = (const bf16_t*)(c.ws + WS_W + W_IN); const bf16_t* Tout = (const bf16_t*)(c.ws + WS_W + W_OUT); const bf16_t* T13 = (const bf16_t*)(c.ws + WS_W + W_13); const bf16_t* T2 = (const bf16_t*)(c.ws + WS_W + W_2);
    bf16_t* HN = (bf16_t*)(c.ws + WS_HN); const bf16_t* HB = (const bf16_t*)(c.ws + WS_H); const float* RSP = (const float*)(c.ws + WS_RS); bf16_t* PROJ = (bf16_t*)(c.ws + WS_BIG + B_PROJ); bf16_t* ACT = (bf16_t*)(c.ws + WS_BIG + B_ACT); float* Y = (float*)(c.ws + WS_BIG + B_Y);
#ifndef PHMASK
#define PHMASK 0x7fffff
#endif
#define RUNOK(k) (((PHMASK >> (k)) & 1) && ph_lo <= (k) && (k) < ph_hi)
#ifndef REPMASK
#define REPMASK 0
#define REPCOUNT 1
#endif
#define REPN(k) ((((REPMASK) >> (k)) & 1) ? (REPCOUNT) : 1)
#define PH(k) for (int rep_ = 0; rep_ < REPN(k); ++rep_, (rep_ < REPN(k) ? (xcd_barrier(xbar), 0) : 0)) if (RUNOK(k))
#define RUN(k) RUNOK(k)
#ifndef OUT_AFTER
#define OUT_AFTER 99
#endif
#define GSYNC() xcd_barrier(xbar)
#ifndef TPROBE
#define TPROBE -1
#endif
#ifndef TSCALE
#define TSCALE 4
#endif
#define SYNC(k) do { if (ph_lo <= (k) && (k) + 1 < ph_hi) { if (ph_lo < 0) grid.sync(); else GSYNC(); } FRESH(); \
    if (TPROBE >= 0 && blockIdx.x == 0 && threadIdx.x == 0) { if ((k) + 1 == TPROBE) ((unsigned long long*)(p.ws + WS_CTL + 1024))[0] = __builtin_amdgcn_s_memrealtime(); if ((k) == TPROBE) ((unsigned long long*)(p.ws + WS_CTL + 1024))[1] = __builtin_amdgcn_s_memrealtime(); } } while (0)
#define FRESH() do { int t_ = threadIdx.x; asm volatile("" : "+v"(t_)); c.tid = t_; c.lane = t_ & 63; c.wave = __builtin_amdgcn_readfirstlane(t_ >> 6); size_t z_ = 0; asm volatile("" : "+s"(z_)); c.ws = p.ws + z_; } while (0)
#define GEMM_BF16(Nn, Kk, Aa, Bb, Oo) do { pg8::Gemm g{Aa, Bb, NREAL, Nn, Kk}; pg8::StaticOrder S; S.init(NREAL, Nn, c.G, c.b); pg8::EpiBf16 E{Oo, Nn, RSP}; pg8::gemm_phase<pg8::EpiBf16, pg8::StaticOrder, true, true>(c.lds, g, S, E); meta_gemm<0>(c, Aa, Kk, Bb, Nn, Oo, Nn, (NREAL / 256) * (Nn / 256), RSP); } while (0)
#define GEMM_F32(Nn, Kk, Aa, Bb, Oo) do { pg8::Gemm g{Aa, Bb, NREAL, Nn, Kk}; pg8::StaticOrder S; S.init(NREAL, Nn, c.G, c.b); pg8::EpiBf16 E{(bf16_t*)(Oo), Nn, nullptr}; pg8::gemm_phase<pg8::EpiBf16, pg8::StaticOrder, true, true>(c.lds, g, S, E); meta_gemm<0>(c, Aa, Kk, Bb, Nn, (bf16_t*)(Oo), Nn, (NREAL / 256) * (Nn / 256), nullptr); } while (0)
#define GEMM_SWIGLU(Aa, Bb, Oo) do { pg8::Gemm g{Aa, Bb, NREAL, 2 * DFF, DM}; pg8::StaticOrder S; S.init(NREAL, 2 * DFF, c.G, c.b); pg8::EpiSwiglu E{Oo, DFF, RSP}; pg8::gemm_phase<pg8::EpiSwiglu, pg8::StaticOrder, true, true>(c.lds, g, S, E); meta_gemm<2>(c, Aa, DM, Bb, 2 * DFF, Oo, DFF, (NREAL / 256) * (2 * DFF / 256), RSP); } while (0)
    { constexpr int layer = 0;
        const int P = layer == 0 ? 0 : 9;
        if (layer == 0) {
            PH(0) { CHK(if (c.b == 0 && c.tid == 0) *(unsigned*)(c.ws + WS_CTL) = 0u;) phase_convert(p, c, 0, 0, c.b * NWAVES + c.wave, c.G * NWAVES); phase_norm0(p, c); }
            SYNC(0);
            PH(1) { GEMM_BF16(N_AB, DM, HB, Tin, PROJ); convert_fill(p, c, 0, 1, (NREAL / 256) * (N_AB / 256)); }
            SYNC(1);
            PH(2) { phase_hgrn<false>(p, c); sconv_part(p, c, 0, c.G); GSYNC(); phase_hgrn_scan(p, c); }
            SYNC(2);
            PH(3) phase_hgrn<true>(p, c);
            SYNC(3);
        } else {
            PH(9) { GEMM_BF16(N_CDP, DM, HB, Tin, PROJ); convert_fill(p, c, 1, 1, (NREAL / 256) * (N_CDP / 256)); }
            SYNC(9);
            PH(10) { }
            PH(11) { dsa_c_part(p, c); phase_gates_v2(p, c); bd_gemm<0>(p, c); }
            SYNC(11);
            PH(12) { rg_scan_s23(p, c);
#ifdef ZERO_ATT
                { bf16_t* MOz = (bf16_t*)(c.ws + WS_HN); for (int i_ = c.b * NTHR + c.tid; i_ < NTOK * 128; i_ += c.G * NTHR) { const int r_ = i_ >> 7, c8_ = (i_ & 127) * 8; *(u32x4*)(MOz + (size_t)r_ * DM + 1024 + c8_) = (u32x4){0u, 0u, 0u, 0u}; } }
#endif
            }
            SYNC(12);
            CHK(if (CHKSET == 2) chk_rg(p, c, 1u); if (CHKSET == 1) chk_rg(p, c, 4u);)
            PH(13) phase_scores_v2(p, c);
            SYNC(13);
            CHK(if (CHKSET == 0) chk_scores(p, c, 1u); if (CHKSET == 1) chk_c(p, c, 1u);)
            PH(14) phase_select_v3(p, c);
            SYNC(14);
            CHK(if (CHKSET == 0) { chk_select(p, c, 2u); grid.sync(); })
            PH(15) { }
            CHK(if (CHKSET == 0) chk_qlat(p, c, 4u);)
            PH(16) phase_attn_flash(p, c);
            SYNC(16);
            CHK(if (CHKSET == 0) chk_attn(p, c, 8u);)
            PH(17) bd_gemm<1>(p, c);
            SYNC(17);
        }
        const int Q = layer == 0 ? 4 : 18;
        CHK(if (layer == 1 && CHKSET == 1) chk_attproj(p, c, 2u);)
        PH(Q) GEMM_F32(DM, DM, HN, Tout, Y);
        SYNC(Q);
        CHK(if (layer == 1 && CHKSET == 2) { chk_gemm(c, HN, DM, DM, p.in[I_CD_OUT], DM, DM, Y, DM, false, 2u); } if (layer == 1) grid.sync();)
        PH(Q + 1) phase_normres(p, c, p.in[I_LN_MIX_POST] + layer * DM, p.in[I_LN_FFN_PRE] + layer * DM, false);
        SYNC(Q + 1);
        PH(Q + 2) { GEMM_SWIGLU(HB, T13, ACT); convert_fill(p, c, layer, 2, (NREAL / 256) * (2 * DFF / 256)); if (layer == 0) convert_fill(p, c, 1, 3, (NREAL / 256) * (2 * DFF / 256)); }
        SYNC(Q + 2);
        CHK(if (layer == 1 && CHKSET == 2) chk_swiglu(c, HN, p.in[I_W1] + (size_t)DM * DFF, p.in[I_W3] + (size_t)DM * DFF, ACT, 4u);)
        PH(Q + 3) GEMM_F32(DM, DFF, ACT, T2, Y);
        SYNC(Q + 3);
        PH(Q + 4) { if (layer == 0) { phase_normres(p, c, p.in[I_LN_FFN_POST], p.in[I_LN_MIX_PRE] + DM, false); phase_convert(p, c, 1, 0, c.b * NWAVES + c.wave, c.G * NWAVES); }
                          else { CHK(if (CHKSET == 2) chk_gemm(c, ACT, DFF, DFF, p.in[I_W2] + (size_t)DFF * DM, DM, DM, Y, DM, false, 4u);) phase_normres(p, c, p.in[I_LN_FFN_POST] + DM, nullptr, true); } }
        if (layer == 0) SYNC(Q + 4);
        (void)P;
    }
    { constexpr int layer = 1;
        const int P = layer == 0 ? 0 : 9;
        if (layer == 0) {
            PH(0) { CHK(if (c.b == 0 && c.tid == 0) *(unsigned*)(c.ws + WS_CTL) = 0u;) phase_convert(p, c, 0, 0, c.b * NWAVES + c.wave, c.G * NWAVES); phase_norm0(p, c); }
            SYNC(0);
            PH(1) { GEMM_BF16(N_AB, DM, HB, Tin, PROJ); convert_fill(p, c, 0, 1, (NREAL / 256) * (N_AB / 256)); }
            SYNC(1);
            PH(2) { phase_hgrn<false>(p, c); sconv_part(p, c, 0, c.G); GSYNC(); phase_hgrn_scan(p, c); }
            SYNC(2);
            PH(3) phase_hgrn<true>(p, c);
            SYNC(3);
        } else {
            PH(9) { GEMM_BF16(N_CDP, DM, HB, Tin, PROJ); convert_fill(p, c, 1, 1, (NREAL / 256) * (N_CDP / 256)); }
            SYNC(9);
            PH(10) { }
            PH(11) { dsa_c_part(p, c); phase_gates_v2(p, c); bd_gemm<0>(p, c); }
            SYNC(11);
            PH(12) { rg_scan_s23(p, c);
#ifdef ZERO_ATT
                { bf16_t* MOz = (bf16_t*)(c.ws + WS_HN); for (int i_ = c.b * NTHR + c.tid; i_ < NTOK * 128; i_ += c.G * NTHR) { const int r_ = i_ >> 7, c8_ = (i_ & 127) * 8; *(u32x4*)(MOz + (size_t)r_ * DM + 1024 + c8_) = (u32x4){0u, 0u, 0u, 0u}; } }
#endif
            }
            SYNC(12);
            CHK(if (CHKSET == 2) chk_rg(p, c, 1u); if (CHKSET == 1) chk_rg(p, c, 4u);)
            PH(13) phase_scores_v2(p, c);
            SYNC(13);
            CHK(if (CHKSET == 0) chk_scores(p, c, 1u); if (CHKSET == 1) chk_c(p, c, 1u);)
            PH(14) phase_select_v3(p, c);
            SYNC(14);
            CHK(if (CHKSET == 0) { chk_select(p, c, 2u); grid.sync(); })
            PH(15) { }
            CHK(if (CHKSET == 0) chk_qlat(p, c, 4u);)
            PH(16) phase_attn_flash(p, c);
            SYNC(16);
            CHK(if (CHKSET == 0) chk_attn(p, c, 8u);)
            PH(17) bd_gemm<1>(p, c);
            SYNC(17);
        }
        const int Q = layer == 0 ? 4 : 18;
        CHK(if (layer == 1 && CHKSET == 1) chk_attproj(p, c, 2u);)
        PH(Q) GEMM_F32(DM, DM, HN, Tout, Y);
        SYNC(Q);
        CHK(if (layer == 1 && CHKSET == 2) { chk_gemm(c, HN, DM, DM, p.in[I_CD_OUT], DM, DM, Y, DM, false, 2u); } if (layer == 1) grid.sync();)
        PH(Q + 1) phase_normres(p, c, p.in[I_LN_MIX_POST] + layer * DM, p.in[I_LN_FFN_PRE] + layer * DM, false);
        SYNC(Q + 1);
        PH(Q + 2) { GEMM_SWIGLU(HB, T13, ACT); convert_fill(p, c, layer, 2, (NREAL / 256) * (2 * DFF / 256)); if (layer == 0) convert_fill(p, c, 1, 3, (NREAL / 256) * (2 * DFF / 256)); }
        SYNC(Q + 2);
        CHK(if (layer == 1 && CHKSET == 2) chk_swiglu(c, HN, p.in[I_W1] + (size_t)DM * DFF, p.in[I_W3] + (size_t)DM * DFF, ACT, 4u);)
        PH(Q + 3) GEMM_F32(DM, DFF, ACT, T2, Y);
        SYNC(Q + 3);
        PH(Q + 4) { if (layer == 0) { phase_normres(p, c, p.in[I_LN_FFN_POST], p.in[I_LN_MIX_PRE] + DM, false); phase_convert(p, c, 1, 0, c.b * NWAVES + c.wave, c.G * NWAVES); }
                          else { CHK(if (CHKSET == 2) chk_gemm(c, ACT, DFF, DFF, p.in[I_W2] + (size_t)DFF * DM, DM, DM, Y, DM, false, 4u);) phase_normres(p, c, p.in[I_LN_FFN_POST] + DM, nullptr, true); } }
        if (layer == 0) SYNC(Q + 4);
        (void)P;
    }
    if (TPROBE >= 0) {
        GSYNC();
        const unsigned long long* tp_ = (const unsigned long long*)(p.ws + WS_CTL + 1024); const unsigned long long d_ = tp_[1] - tp_[0];
        const int R_ = (int)min((unsigned long long)NREAL, d_ * TSCALE / 100ull);
        f32x4* od_ = (f32x4*)p.out; for (int i_ = c.b * NTHR + c.tid; i_ < R_ * (DM / 4); i_ += c.G * NTHR) od_[i_] = (f32x4){0.f, 0.f, 0.f, 0.f};
    }
#ifdef CHECKS
    grid.sync();
    unsigned fl = *(volatile unsigned*)(c.ws + WS_CTL);
    { f32x4* od_ = (f32x4*)p.out;
      for (int i_ = c.b * NTHR + c.tid; i_ < NREAL * DM / 4; i_ += c.G * NTHR) { const int r_ = i_ / (DM / 4);
          const bool z = ((fl & 1u) && r_ < 512) || ((fl & 2u) && r_ >= 512 && r_ < 1536) || ((fl & 4u) && r_ >= 1536 && r_ < 3584) || ((fl & 8u) && r_ >= 3584 && r_ < 7680);
          if (z) od_[i_] = (f32x4){0.f, 0.f, 0.f, 0.f}; } }
#endif
}

extern "C" void kernel_launch(void* const* d_in, const int* in_sizes, int n_in, void* d_out, int out_size, void* d_ws, size_t ws_size, hipStream_t stream) {
    static int grid = 0;
    if (grid == 0) {
        int dev = 0, cus = 0, per_cu = 0;
        hipGetDevice(&dev); hipDeviceGetAttribute(&cus, hipDeviceAttributeMultiprocessorCount, dev);
        hipFuncSetAttribute((const void*)mega, hipFuncAttributeMaxDynamicSharedMemorySize, LDS_BYTES);
        hipOccupancyMaxActiveBlocksPerMultiprocessor(&per_cu, (const void*)mega, NTHR, LDS_BYTES);
        if (per_cu < 1) { fprintf(stderr, "kernel_launch: occupancy query says %d blocks per CU\n", per_cu); per_cu = 1; }
        grid = cus;
        if (ws_size < WS_END) fprintf(stderr, "kernel_launch: workspace %zu < %zu needed\n", ws_size, (size_t)WS_END);
        if (n_in != 26) fprintf(stderr, "kernel_launch: expected 26 inputs, got %d\n", n_in);
    }
    hipMemsetAsync((char*)d_ws + WS_CTL, 0, 65536, stream);
    Params p{};
    for (int i = 0; i < 26; ++i) p.in[i] = (const float*)d_in[i];
    p.out = (float*)d_out; p.ws = (unsigned char*)d_ws;
    int lo = 0, hi = NPHASE;
    void* args[] = {&p, &lo, &hi};
    hipError_t e = hipLaunchCooperativeKernel((const void*)mega, dim3(grid), dim3(NTHR), args, LDS_BYTES, stream);
    if (e != hipSuccess) fprintf(stderr, "cooperative launch failed: %s (grid %d)\n", hipGetErrorString(e), grid);
}
```

```cpp
#include <hip/hip_runtime.h>
#include <hip/hip_cooperative_groups.h>
#include <cstdio>
#include <cstdint>
namespace cg = cooperative_groups;

#define LAS __attribute__((address_space(3)))
typedef unsigned short bf16_t;
typedef short bf16x8 __attribute__((ext_vector_type(8)));
typedef float f32x4 __attribute__((ext_vector_type(4)));
typedef float f32x2 __attribute__((ext_vector_type(2)));
typedef unsigned u32x4 __attribute__((ext_vector_type(4)));
typedef unsigned u32x2 __attribute__((ext_vector_type(2)));

constexpr int NREAL = 8192, NMETA = 16, NTOK = 8208, ROWS = 8448, DM = 2048, DFF = 5632;
constexpr int N_AB = 7168, N_CD = 4432, N_CDP = 4608;
constexpr float EPS = 1e-6f;
constexpr int NTHR = 512, NWAVES = 8;

constexpr size_t WS_CTL = 0;
constexpr size_t WS_RS = 65536;
constexpr size_t WS_W = 1u << 20;
constexpr size_t W_IN = 0, W_OUT = 29360128, W_13 = 37748736, W_2 = 83886080, W_BYTES = 106954752;
constexpr size_t WS_H = WS_W + W_BYTES;
constexpr size_t WS_HN = WS_H + (size_t)ROWS * DM * 4;
constexpr size_t WS_C = WS_HN + (size_t)ROWS * DM * 2;
constexpr size_t WS_IDX = WS_C + (size_t)ROWS * 256 * 2;
constexpr size_t WS_BIG = WS_IDX + (size_t)NREAL * 256 * 4;
constexpr size_t B_PROJ = 0, B_ACT = 0;
constexpr size_t B_Y = (size_t)ROWS * N_AB * 2;
constexpr size_t B_HO = B_Y;
constexpr size_t B_L1 = (size_t)ROWS * N_CDP * 2;
constexpr size_t B_U = B_L1, B_A = B_U + (size_t)ROWS * 1024 * 4, B_X = B_A + (size_t)ROWS * 1024 * 4;
constexpr size_t B_SC = B_L1;
constexpr size_t B_OL = B_L1 + (size_t)ROWS * DM * 2;
constexpr size_t WS_QL = WS_H + (size_t)ROWS * DM * 2;
constexpr size_t SC_BYTES = (size_t)16384 * 2080 * 4;
constexpr size_t BIG_BYTES = B_SC + SC_BYTES;
constexpr size_t WS_GM = WS_BIG + BIG_BYTES;
constexpr size_t WS_END = WS_GM + (size_t)NREAL * 1024 * 2;

struct Params { const float* in[26]; float* out; unsigned char* ws; };
enum { I_X = 0, I_META, I_LN_MIX_PRE, I_LN_MIX_POST, I_LN_FFN_PRE, I_LN_FFN_POST, I_W1, I_W3, I_W2, I_AB_IN, I_AB_OUT, I_LB, I_HG_NORM, I_SCONV,
       I_CD_IN, I_CD_OUT, I_RG_CW, I_RG_CB, I_RG_WA, I_RG_BA, I_RG_WI, I_RG_BI, I_RG_LAM, I_KVN, I_WUK, I_WUV };

__device__ __forceinline__ int row_of(int t) { return t < NMETA ? NREAL + t : t - NMETA; }
template <int CTRL> __device__ __forceinline__ float dpp_f(float x) { return __builtin_bit_cast(float, __builtin_amdgcn_mov_dpp(__builtin_bit_cast(int, x), CTRL, 0xf, 0xf, true)); }
__device__ __forceinline__ float row16_sum(float x) { x += dpp_f<0xB1>(x); x += dpp_f<0x4E>(x); x += dpp_f<0x124>(x); x += dpp_f<0x128>(x); return x; }
__device__ __forceinline__ float row16_max(float x) { x = fmaxf(x, dpp_f<0xB1>(x)); x = fmaxf(x, dpp_f<0x4E>(x)); x = fmaxf(x, dpp_f<0x124>(x)); x = fmaxf(x, dpp_f<0x128>(x)); return x; }
__device__ __forceinline__ float xrow16_sum(float x) {
    auto s = __builtin_amdgcn_permlane16_swap(__float_as_uint(x), __float_as_uint(x), false, false); x = __uint_as_float(s[0]) + __uint_as_float(s[1]);
    auto t = __builtin_amdgcn_permlane32_swap(__float_as_uint(x), __float_as_uint(x), false, false); return __uint_as_float(t[0]) + __uint_as_float(t[1]); }
__device__ __forceinline__ float xrow16_max(float x) {
    auto s = __builtin_amdgcn_permlane16_swap(__float_as_uint(x), __float_as_uint(x), false, false); x = fmaxf(__uint_as_float(s[0]), __uint_as_float(s[1]));
    auto t = __builtin_amdgcn_permlane32_swap(__float_as_uint(x), __float_as_uint(x), false, false); return fmaxf(__uint_as_float(t[0]), __uint_as_float(t[1])); }
template <int CTRL, int ROWMASK> __device__ __forceinline__ float dpp_z(float x) { return __builtin_bit_cast(float, __builtin_amdgcn_update_dpp(0, __builtin_bit_cast(int, x), CTRL, ROWMASK, 0xf, true)); }
__device__ __forceinline__ float scan32_incl(float x) { x += dpp_z<0x111, 0xf>(x); x += dpp_z<0x112, 0xf>(x); x += dpp_z<0x114, 0xf>(x); x += dpp_z<0x118, 0xf>(x); x += dpp_z<0x142, 0xa>(x); return x; }
__device__ __forceinline__ float wave_sum(float v) { return xrow16_sum(row16_sum(v)); }
__device__ __forceinline__ float wave_max(float v) { return xrow16_max(row16_max(v)); }
typedef __bf16 bf16x2_t __attribute__((ext_vector_type(2)));
__device__ __forceinline__ unsigned pk2(float lo, float hi) { const f32x2 v = {lo, hi}; const bf16x2_t b = __builtin_convertvector(v, bf16x2_t); return __builtin_bit_cast(unsigned, b); }
__device__ __forceinline__ unsigned f2bf(float f) { return pk2(f, f) & 0xffffu; }
__device__ __forceinline__ float bf2f(unsigned b) { return __uint_as_float(b << 16); }
__device__ __forceinline__ float bflo(unsigned w) { return __uint_as_float(w << 16); }
__device__ __forceinline__ float bfhi(unsigned w) { return __uint_as_float(w & 0xffff0000u); }
__device__ __forceinline__ float sigmoidf_(float x) { return __builtin_amdgcn_rcpf(1.0f + __expf(-x)); }
__device__ __forceinline__ float siluf_(float x) { return x * __builtin_amdgcn_rcpf(1.0f + __expf(-x)); }
__device__ __forceinline__ float gelu_tanh(float x) { const float u = 0.7978845608028654f * (x + 0.044715f * x * x * x); return x * __builtin_amdgcn_rcpf(1.0f + __expf(-2.0f * u)); }

namespace pg8 {
#define PG8_LAS __attribute__((address_space(3)))
constexpr int BM = 256, BK = 64, HALF = 128, HTB = HALF * BK * 2, STAGE_BYTES = 8 * HTB, NXCD = 8, WGM = 4;
__host__ __device__ __forceinline__ int lds_byte(int r, int c) { const int st = (r >> 4) * 2 + (c >> 5), rr = r & 15, cc = c & 31, ob = rr * 64 + cc * 2; return st * 1024 + (ob ^ (((ob >> 9) & 1) << 5)); }
__host__ __device__ __forceinline__ void stage_rc(int b, int& R, int& C) { const int st = b / 1024, sb = b % 1024, swz = sb ^ (((sb >> 9) & 1) << 5); R = (st >> 1) * 16 + swz / 64; C = (st & 1) * 32 + (swz % 64) / 2; }
__host__ __device__ __forceinline__ int perm32(int rho) { const int n = rho >> 4, i = rho & 15; return 8 * (i >> 2) + 4 * n + (i & 3); }
struct Unit { int pm, pn; };
struct Gemm { const bf16_t* A; const bf16_t* Bt; int M, N, K; };
struct StaticOrder {
    int nM, nN, nwg, G, c;
    __host__ __device__ void init(int M, int N, int G_, int c_) { nM = M / BM; nN = N / BM; nwg = nM * nN; G = G_; c = c_; }
    __host__ __device__ bool next(int i, Unit& u) const {
        const long L = (long)i * G + c; if (L >= nwg) return false;
        int wgid = (int)L; { const int q = nwg / NXCD, r = nwg % NXCD, xcd = wgid % NXCD, off = wgid / NXCD; wgid = (xcd < r ? xcd * (q + 1) : r * (q + 1) + (xcd - r) * q) + off; }
        const int nig = WGM * nN, gid = wgid / nig, fm = gid * WGM, gsz = (nM - fm) < WGM ? (nM - fm) : WGM;
        u.pm = fm + ((wgid % nig) % gsz); u.pn = (wgid % nig) / gsz; return true;
    }
    __device__ __forceinline__ void a_ready(const Unit&) const {}
    __device__ __forceinline__ void done(const Unit&) const {}
};
__device__ __forceinline__ unsigned cvt_pk_bf16(float lo, float hi) { return pk2(lo, hi); }

struct EpiBf16 {
    static constexpr bool PERM = true, AFTER_DRAIN = false;
    bf16_t* O; int ldc; const float* rs;
    __device__ __forceinline__ void operator()(const f32x4 (&acc)[2][2][4][2], const Unit& u, int wr, int wc, int fr, int fq) const {
        const int row0 = u.pm * BM + wr * 64 + fr; const int col0 = u.pn * BM + wc * 32 + 8 * fq;
#pragma unroll
        for (int ai = 0; ai < 2; ++ai)
#pragma unroll
            for (int m = 0; m < 4; ++m) { bf16_t* rowp = O + (size_t)(row0 + ai * HALF + m * 16) * ldc + col0; const float sc = rs ? rs[row0 + ai * HALF + m * 16] : 1.0f;
#pragma unroll
                for (int bj = 0; bj < 2; ++bj) { const f32x4 v0 = acc[ai][bj][m][0] * sc, v1 = acc[ai][bj][m][1] * sc;
                    u32x4 w; w.x = cvt_pk_bf16(v0[0], v0[1]); w.y = cvt_pk_bf16(v0[2], v0[3]); w.z = cvt_pk_bf16(v1[0], v1[1]); w.w = cvt_pk_bf16(v1[2], v1[3]);
                    *(u32x4*)(rowp + bj * HALF) = w; } }
    }
};
struct EpiSwiglu {
    static constexpr bool PERM = true, AFTER_DRAIN = false;
    bf16_t* O; int ldc; const float* rs;
    __device__ __forceinline__ void operator()(const f32x4 (&acc)[2][2][4][2], const Unit& u, int wr, int wc, int fr, int fq) const {
        const int row0 = u.pm * BM + wr * 64 + fr; const int col0 = u.pn * HALF + wc * 32 + 8 * fq;
#pragma unroll
        for (int ai = 0; ai < 2; ++ai)
#pragma unroll
            for (int m = 0; m < 4; ++m) { bf16_t* rowp = O + (size_t)(row0 + ai * HALF + m * 16) * ldc + col0; const float sc = rs[row0 + ai * HALF + m * 16];
                float r[8];
#pragma unroll
                for (int n = 0; n < 2; ++n)
#pragma unroll
                    for (int j = 0; j < 4; ++j) { const float a = acc[ai][0][m][n][j] * sc, b = acc[ai][1][m][n][j] * sc; r[n * 4 + j] = a * __builtin_amdgcn_rcpf(1.0f + __expf(-a)) * b; }
                u32x4 w; w.x = cvt_pk_bf16(r[0], r[1]); w.y = cvt_pk_bf16(r[2], r[3]); w.z = cvt_pk_bf16(r[4], r[5]); w.w = cvt_pk_bf16(r[6], r[7]);
                *(u32x4*)rowp = w; }
    }
};
struct EpiF32 {
    static constexpr bool PERM = false, AFTER_DRAIN = false;
    float* C; int ldc;
    __device__ __forceinline__ void operator()(const f32x4 (&acc)[2][2][4][2], const Unit& u, int wr, int wc, int fr, int fq) const {
        const int row0 = u.pm * BM + wr * 64 + fr, col0 = u.pn * BM + wc * 32 + 4 * fq;
#pragma unroll
        for (int ai = 0; ai < 2; ++ai)
#pragma unroll
            for (int m = 0; m < 4; ++m) { float* rowp = C + (size_t)(row0 + ai * HALF + m * 16) * ldc + col0;
#pragma unroll
                for (int bj = 0; bj < 2; ++bj)
#pragma unroll
                    for (int n = 0; n < 2; ++n) *(f32x4*)(rowp + bj * HALF + n * 16) = acc[ai][bj][m][n]; }
    }
};

template <class Epi, class Sched, bool ALIGN_EPI = false, bool SP2 = false>
__device__ __forceinline__ void gemm_phase(PG8_LAS unsigned char* lds, const Gemm g, const Sched& S, const Epi& E) {
    int tid_ = threadIdx.x; asm volatile("" : "+v"(tid_)); const int tid = tid_, wid = __builtin_amdgcn_readfirstlane(tid >> 6), lane = tid & 63, wr = wid >> 2, wc = wid & 3, fr = lane & 15, fq = lane >> 4;
    const int K = g.K, nt = K / BK;
    unsigned voffA[2], voffB[2];
#pragma unroll
    for (int i = 0; i < 2; ++i) { int R, C; stage_rc(tid * 16 + i * 8192, R, C); const int Rb = Epi::PERM ? ((R & ~31) + perm32(R & 31)) : R;
        voffA[i] = (unsigned)(R * K + C) * 2u; voffB[i] = (unsigned)(Rb * K + C) * 2u; }
    const size_t kstep = (size_t)(BK * 2);
    const size_t hstep = (size_t)HALF * K * 2;
    const size_t tstep = 2 * hstep;
    const unsigned ldsw = (unsigned)wid * 1024u;
    const int aoff = lds_byte(wr * 64 + fr, fq * 8), boff = lds_byte(wc * 32 + fr, fq * 8);
#define PG8_SA(b, h) (((b) * 2 + (h)) * HTB)
#define PG8_SB(b, h) ((4 + (b) * 2 + (h)) * HTB)
#define PG8_STAGE(bufoff, gbase, voff) do { _Pragma("unroll") for (int _i = 0; _i < 2; ++_i) \
        __builtin_amdgcn_global_load_lds((const unsigned*)((const char*)(gbase) + (voff)[_i]), (PG8_LAS unsigned*)(lds + (bufoff) + ldsw + _i * 8192), 16, 0, 0); } while (0)
#define PG8_LDA(dst, b, h) do { _Pragma("unroll") for (int m = 0; m < 4; ++m) _Pragma("unroll") for (int k = 0; k < 2; ++k) dst[m][k] = *(const PG8_LAS bf16x8*)(lds + PG8_SA(b, h) + aoff + m * 2048 + k * 1024); } while (0)
#define PG8_LDB(dst, b, h) do { _Pragma("unroll") for (int n = 0; n < 2; ++n) _Pragma("unroll") for (int k = 0; k < 2; ++k) dst[n][k] = *(const PG8_LAS bf16x8*)(lds + PG8_SB(b, h) + boff + n * 2048 + k * 1024); } while (0)
#define PG8_MMA(ai, bj, At, Bt) do { __builtin_amdgcn_s_setprio(1); _Pragma("unroll") for (int m = 0; m < 4; ++m) _Pragma("unroll") for (int n = 0; n < 2; ++n) _Pragma("unroll") for (int k = 0; k < 2; ++k) \
        acc[ai][bj][m][n] = __builtin_amdgcn_mfma_f32_16x16x32_bf16(Bt[n][k], At[m][k], acc[ai][bj][m][n], 0, 0, 0); __builtin_amdgcn_s_setprio(0); } while (0)
#define PG8_WAIT_V(n) asm volatile("s_waitcnt vmcnt(" #n ")" ::: "memory")
#define PG8_WAIT_L(n) asm volatile("s_waitcnt lgkmcnt(" #n ")" ::: "memory")
#define PG8_BAR __builtin_amdgcn_s_barrier()
#define PG8_SCHED __builtin_amdgcn_sched_barrier(0)
    Unit cur, nxt; int ui = 0;
    if (!S.next(0, cur)) return;
    f32x4 acc[2][2][4][2];
#pragma unroll
    for (int a = 0; a < 2; ++a)
#pragma unroll
        for (int b = 0; b < 2; ++b)
#pragma unroll
            for (int m = 0; m < 4; ++m)
#pragma unroll
                for (int n = 0; n < 2; ++n) acc[a][b][m][n] = (f32x4){0.f, 0.f, 0.f, 0.f};
    bf16x8 At[4][2], B0[2][2], B1[2][2];
    const char* cA = (const char*)g.A + (size_t)cur.pm * tstep; const char* cB = (const char*)g.Bt + (size_t)cur.pn * tstep;
    S.a_ready(cur);
    if constexpr (SP2) {
        PG8_STAGE(PG8_SB(0, 0), cB, voffB); PG8_STAGE(PG8_SB(0, 1), cB + hstep, voffB); PG8_STAGE(PG8_SA(0, 0), cA, voffA); PG8_STAGE(PG8_SA(0, 1), cA + hstep, voffA);
        if (wr == 1) PG8_BAR;
        PG8_WAIT_V(2); PG8_BAR;
        PG8_STAGE(PG8_SB(1, 0), cB + kstep, voffB); PG8_STAGE(PG8_SA(1, 0), cA + kstep, voffA); PG8_STAGE(PG8_SB(1, 1), cB + hstep + kstep, voffB);
        PG8_WAIT_V(6); PG8_BAR;
    } else {
        PG8_STAGE(PG8_SB(0, 0), cB, voffB); PG8_STAGE(PG8_SA(0, 0), cA, voffA); PG8_STAGE(PG8_SB(0, 1), cB + hstep, voffB); PG8_STAGE(PG8_SA(0, 1), cA + hstep, voffA);
        if (wr == 1) PG8_BAR;
        PG8_WAIT_V(4); PG8_BAR;
        PG8_STAGE(PG8_SB(1, 0), cB + kstep, voffB); PG8_STAGE(PG8_SA(1, 0), cA + kstep, voffA); PG8_STAGE(PG8_SB(1, 1), cB + hstep + kstep, voffB);
        PG8_WAIT_V(6); PG8_BAR;
    }
    for (;;) {
        const bool has_next = S.next(ui + 1, nxt);
        const char* nA = has_next ? (const char*)g.A + (size_t)nxt.pm * tstep : cA; const char* nB = has_next ? (const char*)g.Bt + (size_t)nxt.pn * tstep : cB;
        for (int t = 0; t < nt; t += 2) {
            const bool last = (t == nt - 2);
            const char* a1 = cA + (size_t)(t + 1) * kstep;
            const char* a2 = last ? nA : cA + (size_t)(t + 2) * kstep; const char* b2 = last ? nB : cB + (size_t)(t + 2) * kstep;
            const char* a3 = a2 + kstep; const char* b3 = b2 + kstep;
            if (last && has_next) S.a_ready(nxt);
            if constexpr (SP2) {
            PG8_LDB(B0, 0, 0); PG8_LDB(B1, 0, 1); PG8_SCHED; PG8_LDA(At, 0, 0); PG8_STAGE(PG8_SA(1, 1), a1 + hstep, voffA);
            PG8_WAIT_V(8); PG8_WAIT_L(0); PG8_BAR; PG8_MMA(0, 0, At, B0); PG8_MMA(0, 1, At, B1); PG8_BAR; PG8_SCHED;
            PG8_LDA(At, 0, 1); PG8_STAGE(PG8_SB(0, 0), b2, voffB); PG8_STAGE(PG8_SB(0, 1), b2 + hstep, voffB); PG8_STAGE(PG8_SA(0, 0), a2, voffA);
            PG8_WAIT_V(8); PG8_WAIT_L(0); PG8_BAR; PG8_MMA(1, 0, At, B0); PG8_MMA(1, 1, At, B1); PG8_BAR; PG8_SCHED;
            PG8_LDB(B0, 1, 0); PG8_LDB(B1, 1, 1); PG8_SCHED; PG8_LDA(At, 1, 0); PG8_STAGE(PG8_SA(0, 1), a2 + hstep, voffA);
            PG8_WAIT_V(8); PG8_WAIT_L(0); PG8_BAR; PG8_MMA(0, 0, At, B0); PG8_MMA(0, 1, At, B1); PG8_BAR; PG8_SCHED;
            PG8_LDA(At, 1, 1); PG8_STAGE(PG8_SB(1, 0), b3, voffB); PG8_STAGE(PG8_SB(1, 1), b3 + hstep, voffB); PG8_STAGE(PG8_SA(1, 0), a3, voffA);
            PG8_WAIT_V(8); PG8_WAIT_L(0); PG8_BAR; PG8_MMA(1, 0, At, B0); PG8_MMA(1, 1, At, B1); PG8_BAR; PG8_SCHED;
            } else {
            PG8_LDB(B0, 0, 0); PG8_SCHED; PG8_LDA(At, 0, 0); PG8_STAGE(PG8_SA(1, 1), a1 + hstep, voffA);
            PG8_WAIT_L(8); PG8_BAR; PG8_WAIT_L(0); PG8_MMA(0, 0, At, B0); PG8_BAR; PG8_SCHED;
            PG8_LDB(B1, 0, 1); PG8_STAGE(PG8_SB(0, 0), b2, voffB);
            PG8_BAR; PG8_WAIT_L(0); PG8_MMA(0, 1, At, B1); PG8_BAR;
            PG8_LDA(At, 0, 1); PG8_STAGE(PG8_SA(0, 0), a2, voffA);
            PG8_BAR; PG8_WAIT_L(0); PG8_MMA(1, 0, At, B0); PG8_BAR; PG8_SCHED;
            PG8_STAGE(PG8_SB(0, 1), b2 + hstep, voffB);
            PG8_WAIT_V(6); PG8_BAR; PG8_MMA(1, 1, At, B1); PG8_BAR;
            PG8_LDB(B0, 1, 0); PG8_SCHED; PG8_LDA(At, 1, 0); PG8_STAGE(PG8_SA(0, 1), a2 + hstep, voffA);
            PG8_WAIT_L(8); PG8_BAR; PG8_WAIT_L(0); PG8_MMA(0, 0, At, B0); PG8_BAR; PG8_SCHED;
            PG8_LDB(B1, 1, 1); PG8_STAGE(PG8_SB(1, 0), b3, voffB);
            PG8_BAR; PG8_WAIT_L(0); PG8_MMA(0, 1, At, B1); PG8_BAR;
            PG8_LDA(At, 1, 1); PG8_STAGE(PG8_SA(1, 0), a3, voffA);
            PG8_BAR; PG8_WAIT_L(0); PG8_MMA(1, 0, At, B0); PG8_BAR; PG8_SCHED;
            PG8_STAGE(PG8_SB(1, 1), b3 + hstep, voffB);
            PG8_WAIT_V(6); PG8_BAR; PG8_MMA(1, 1, At, B1); PG8_BAR;
            }
        }
        if constexpr (ALIGN_EPI) { if (wr == 0) PG8_BAR; }
        if constexpr (!Epi::AFTER_DRAIN) { E(acc, cur, wr, wc, fr, fq); S.done(cur); }
        if (!has_next) break;
#pragma unroll
        for (int a = 0; a < 2; ++a)
#pragma unroll
            for (int b = 0; b < 2; ++b)
#pragma unroll
                for (int m = 0; m < 4; ++m)
#pragma unroll
                    for (int n = 0; n < 2; ++n) acc[a][b][m][n] = (f32x4){0.f, 0.f, 0.f, 0.f};
        cur = nxt; cA = nA; cB = nB; ++ui;
        if constexpr (ALIGN_EPI) { if (wr == 1) PG8_BAR; }
    }
    PG8_WAIT_V(0);
    if constexpr (!ALIGN_EPI) { if (wr == 0) PG8_BAR; }
    PG8_BAR;
    if constexpr (Epi::AFTER_DRAIN) { E.fused(acc, cur, wr, wc, fr, fq, lds, wid, lane); S.done(cur); }
#undef PG8_SA
#undef PG8_SB
#undef PG8_STAGE
#undef PG8_LDA
#undef PG8_LDB
#undef PG8_MMA
#undef PG8_WAIT_V
#undef PG8_WAIT_L
#undef PG8_BAR
#undef PG8_SCHED
}
}

#define XB_TMO      128
#define XB_XCNT(j)  (256  + 64 * (j))
#define XB_XSUB(j)  (1280 + 64 * (j))
#define XB_XGEN(j)  (2304 + 64 * (j))
#define XB_TOP      3328
#define XB_TOPGEN   3392
#define XCD_BAR_WORDS 3456
#define XB_SPIN_CAP (1u << 18)

__device__ __forceinline__ unsigned xb_ld(unsigned* p)              { return __hip_atomic_load(p, __ATOMIC_RELAXED, __HIP_MEMORY_SCOPE_AGENT); }
__device__ __forceinline__ unsigned xb_add(unsigned* p, unsigned v) { return __hip_atomic_fetch_add(p, v, __ATOMIC_RELAXED, __HIP_MEMORY_SCOPE_AGENT); }
__device__ __forceinline__ unsigned xb_xcc_id() { return (unsigned)__builtin_amdgcn_s_getreg((3 << 11) | 20) & 0xFu; }
#define XB_SPIN(cond, bar) do { unsigned _sp = 0; while (cond) { __builtin_amdgcn_s_sleep(1); \
    if ((++_sp & 255u) == 0u) { if (xb_ld(&(bar)[XB_TMO])) break; if (_sp > XB_SPIN_CAP) { atomicAdd(&(bar)[XB_TMO], 1u); break; } } } } while (0)

struct XcdBarrier {
    unsigned* bar; unsigned x;
    volatile LAS unsigned* st;
};

__device__ __forceinline__ XcdBarrier xcd_barrier_post(unsigned* bar, volatile LAS unsigned* st) {
    XcdBarrier b; b.bar = bar; b.x = xb_xcc_id(); b.st = st;
    if (threadIdx.x == 0) (void)xb_add(&bar[XB_XCNT(b.x)], 1u);
    return b;
}
__device__ __forceinline__ void xcd_barrier_complete(unsigned* bar, unsigned x, unsigned& nloc, unsigned& nx) {
    const unsigned G = gridDim.x * gridDim.y * gridDim.z;
    unsigned sum, cnt, mine, sp = 0u;
    for (;;) {
        sum = 0u; cnt = 0u; mine = 0u;
#pragma unroll
        for (unsigned j = 0; j < 16; ++j) { const unsigned c = xb_ld(&bar[XB_XCNT(j)]); sum += c; cnt += (c > 0u) ? 1u : 0u; mine = (j == x) ? c : mine; }
        if (sum == G) break;
        __builtin_amdgcn_s_sleep(1);
        if ((++sp & 255u) == 0u) { if (xb_ld(&bar[XB_TMO])) break; if (sp > XB_SPIN_CAP) { atomicAdd(&bar[XB_TMO], 1u); break; } }
    }
    nloc = mine > 0u ? mine : 1u; nx = cnt > 0u ? cnt : 1u;
}

__device__ __forceinline__ void xcd_barrier(const XcdBarrier& b) {
    asm volatile("s_waitcnt vmcnt(0)" ::: "memory");
    __syncthreads();
    if (threadIdx.x == 0) {
        unsigned* bar = b.bar;
        __builtin_amdgcn_s_waitcnt(0);
        unsigned nloc = b.st[0], nx = b.st[1];
        if (nloc == 0u) { xcd_barrier_complete(bar, b.x, nloc, nx); b.st[0] = nloc; b.st[1] = nx; }
        const unsigned old = xb_add(&bar[XB_XSUB(b.x)], 1u);
        const unsigned gen = old / nloc;
        if (old + 1u == (gen + 1u) * nloc) {
            __builtin_amdgcn_fence(__ATOMIC_RELEASE, "agent");
            asm volatile("s_waitcnt vmcnt(0)" ::: "memory");
            const unsigned og = xb_add(&bar[XB_TOP], 1u);
            const unsigned tg = og / nx;
            if (og + 1u == (tg + 1u) * nx) xb_add(&bar[XB_TOPGEN], 1u);
            else XB_SPIN(xb_ld(&bar[XB_TOPGEN]) == tg, bar);
            __builtin_amdgcn_fence(__ATOMIC_ACQUIRE, "agent");
            xb_add(&bar[XB_XGEN(b.x)], 1u);
            asm volatile("s_waitcnt vmcnt(0)" ::: "memory");
        } else {
            XB_SPIN(xb_ld(&bar[XB_XGEN(b.x)]) == gen, bar);
            __builtin_amdgcn_fence(__ATOMIC_ACQUIRE, "agent");
            asm volatile("s_waitcnt vmcnt(0)" ::: "memory");
        }
    }
    __syncthreads();
}

struct Ctx { LAS unsigned char* lds; unsigned char* ws; int tid, lane, wave, G, b; };
#define LDS_WAIT() asm volatile("s_waitcnt lgkmcnt(0)" ::: "memory")

__device__ __forceinline__ void transpose_item(const float* W, int K, int N, bf16_t* WT, int dst_row0, LAS float* scr, int k0, int n0, int lane, const float* gk = nullptr) {
    float tv[32];
#pragma unroll
    for (int i = 0; i < 32; ++i) { const int kk = 2 * i + (lane >> 5); tv[i] = (n0 + (lane & 31)) < N ? __builtin_nontemporal_load(W + (size_t)(k0 + kk) * N + n0 + (lane & 31)) : 0.f; }
#pragma unroll
    for (int i = 0; i < 32; ++i) { const int kk = 2 * i + (lane >> 5); scr[kk * 33 + (lane & 31)] = tv[i]; }
    LDS_WAIT();
    const int c = lane & 7;
    f32x4 ga = (f32x4){1.f, 1.f, 1.f, 1.f}, gb = ga; if (gk) { ga = *(const f32x4*)(gk + k0 + 8 * c); gb = *(const f32x4*)(gk + k0 + 8 * c + 4); }
#pragma unroll
    for (int j = 0; j < 4; ++j) { const int n = (lane >> 3) + 8 * j; const LAS float* s = scr + (8 * c) * 33 + n;
        u32x4 o; o.x = pk2(s[0 * 33] * ga[0], s[1 * 33] * ga[1]); o.y = pk2(s[2 * 33] * ga[2], s[3 * 33] * ga[3]); o.z = pk2(s[4 * 33] * gb[0], s[5 * 33] * gb[1]); o.w = pk2(s[6 * 33] * gb[2], s[7 * 33] * gb[3]);
        *(u32x4*)(WT + (size_t)(dst_row0 + n) * K + k0 + 8 * c) = o; }
    LDS_WAIT();
}
__device__ __forceinline__ int conv_hidden_13(int layer) { return layer == 0 ? 11264 : 11264; }
__device__ __forceinline__ void phase_convert(const Params& p, const Ctx& c, int layer, int part, int gw, int NGW) {
    LAS float* scr = (LAS float*)(c.lds) + c.wave * (64 * 33);
    const float* Win = layer == 0 ? p.in[I_AB_IN] : p.in[I_CD_IN]; const int Nin = layer == 0 ? N_AB : N_CD;
    const float* Wout = layer == 0 ? p.in[I_AB_OUT] : p.in[I_CD_OUT];
    const float* W1 = p.in[I_W1] + (size_t)layer * DM * DFF; const float* W3 = p.in[I_W3] + (size_t)layer * DM * DFF; const float* W2 = p.in[I_W2] + (size_t)layer * DFF * DM;
    bf16_t* Tin = (bf16_t*)(c.ws + WS_W + W_IN); bf16_t* Tout = (bf16_t*)(c.ws + WS_W + W_OUT); bf16_t* T13 = (bf16_t*)(c.ws + WS_W + W_13); bf16_t* T2 = (bf16_t*)(c.ws + WS_W + W_2);
    const int i_in = (DM / 64) * ((Nin + 31) / 32), i_out = (DM / 64) * (DM / 32), i_13 = (DM / 64) * (DFF / 32), i_2 = (DFF / 64) * (DM / 32);
    const int total = i_in + i_out + 2 * i_13 + i_2, cut1 = layer == 0 ? i_in : i_in + i_out + 2 * i_13 - conv_hidden_13(layer), cut2 = i_in + i_out + 2 * i_13;
    int lo = part == 0 ? 0 : part == 1 ? cut1 : cut2, hi = part == 0 ? cut1 : part == 1 ? cut2 : total;
    if (part == 3) { lo = i_in; hi = i_in + i_out; }
    if (layer == 1 && part == 0) hi = i_in;
    for (int it = lo + gw; it < hi; it += NGW) {
        int r = it;
        if (r < i_in) { const int nb = (Nin + 31) / 32, kb = r / nb, n0 = 32 * (r % nb); transpose_item(Win, DM, Nin, Tin, n0, scr, 64 * kb, n0, c.lane, p.in[I_LN_MIX_PRE] + layer * DM); continue; } r -= i_in;
        if (r < i_out) { const int nb = DM / 32, kb = r / nb, n0 = 32 * (r % nb); transpose_item(Wout, DM, DM, Tout, n0, scr, 64 * kb, n0, c.lane); continue; } r -= i_out;
        if (r < i_13) { const int nb = DFF / 32, kb = r / nb, n0 = 32 * (r % nb); transpose_item(W1, DM, DFF, T13, (n0 >> 7) * 256 + (n0 & 127), scr, 64 * kb, n0, c.lane, p.in[I_LN_FFN_PRE] + layer * DM); continue; } r -= i_13;
        if (r < i_13) { const int nb = DFF / 32, kb = r / nb, n0 = 32 * (r % nb); transpose_item(W3, DM, DFF, T13, (n0 >> 7) * 256 + 128 + (n0 & 127), scr, 64 * kb, n0, c.lane, p.in[I_LN_FFN_PRE] + layer * DM); continue; } r -= i_13;
        { const int nb = DM / 32, kb = r / nb, n0 = 32 * (r % nb); transpose_item(W2, DFF, DM, T2, n0, scr, 64 * kb, n0, c.lane); }
    }
    if (layer == 1 && part == 0) {
        u32x4* z = (u32x4*)(Tin + (size_t)4448 * DM); const int n16 = (N_CDP - 4448) * DM * 2 / 16;
        for (int i = c.b * NTHR + c.tid; i < n16; i += c.G * NTHR) z[i] = (u32x4){0u, 0u, 0u, 0u};
    }
}

__device__ __forceinline__ void phase_norm0(const Params& p, const Ctx& c) {
    bf16_t* H = (bf16_t*)(c.ws + WS_H); bf16_t* HN = (bf16_t*)(c.ws + WS_HN); const float* g = p.in[I_LN_MIX_PRE];
    for (int r = c.b * NWAVES + c.wave; r < NTOK; r += c.G * NWAVES) {
        u32x2* hrow = (u32x2*)(H + (size_t)r * DM); u32x2* nrow = (u32x2*)(HN + (size_t)r * DM);
        const f32x4* src = (const f32x4*)(r < NREAL ? p.in[I_X] + (size_t)r * DM : p.in[I_META] + (size_t)(r - NREAL) * DM);
        f32x4 v[8]; float ss = 0.f;
#pragma unroll
        for (int j = 0; j < 8; ++j) { v[j] = __builtin_nontemporal_load(src + c.lane + 64 * j); ss += v[j][0] * v[j][0] + v[j][1] * v[j][1] + v[j][2] * v[j][2] + v[j][3] * v[j][3]; }
        const float rstd = 1.0f / sqrtf(wave_sum(ss) * (1.0f / DM) + EPS);
#pragma unroll
        for (int j = 0; j < 8; ++j) hrow[c.lane + 64 * j] = (u32x2){pk2(v[j][0], v[j][1]), pk2(v[j][2], v[j][3])};
        if (c.lane == 0) ((float*)(c.ws + WS_RS))[r] = rstd;
    }
}
__device__ __forceinline__ void phase_normres(const Params& p, const Ctx& c, const float* gpost, const float* gnext, bool final_) {
    bf16_t* H = (bf16_t*)(c.ws + WS_H); bf16_t* HN = (bf16_t*)(c.ws + WS_HN); const bf16_t* Y = (const bf16_t*)(c.ws + WS_BIG + B_Y);
    const int nrows = final_ ? NREAL : NTOK;
    for (int r = c.b * NWAVES + c.wave; r < nrows; r += c.G * NWAVES) {
        u32x4* hrow = (u32x4*)(H + (size_t)r * DM); const u32x4* yrow = (const u32x4*)(Y + (size_t)r * DM);
        u32x4 yr[4], hr[4];
#pragma unroll
        for (int j = 0; j < 4; ++j) { yr[j] = __builtin_nontemporal_load(yrow + c.lane + 64 * j); hr[j] = hrow[c.lane + 64 * j]; }
        float y[4][8]; float ss = 0.f;
#pragma unroll
        for (int j = 0; j < 4; ++j) { const unsigned wv[4] = {yr[j].x, yr[j].y, yr[j].z, yr[j].w};
#pragma unroll
            for (int i = 0; i < 4; ++i) { y[j][2 * i] = bflo(wv[i]); y[j][2 * i + 1] = bfhi(wv[i]); ss += y[j][2 * i] * y[j][2 * i] + y[j][2 * i + 1] * y[j][2 * i + 1]; } }
        const float rstd = 1.0f / sqrtf(wave_sum(ss) * (1.0f / DM) + EPS);
        float s2 = 0.f;
#pragma unroll
        for (int j = 0; j < 4; ++j) { const int col = (c.lane + 64 * j) * 8; const f32x4 g0 = *(const f32x4*)(gpost + col), g1 = *(const f32x4*)(gpost + col + 4); const unsigned hv[4] = {hr[j].x, hr[j].y, hr[j].z, hr[j].w};
#pragma unroll
            for (int i = 0; i < 4; ++i) { const float ga = i < 2 ? g0[2 * i] : g1[2 * i - 4], gb = i < 2 ? g0[2 * i + 1] : g1[2 * i - 3];
                y[j][2 * i] = bflo(hv[i]) + y[j][2 * i] * rstd * ga; y[j][2 * i + 1] = bfhi(hv[i]) + y[j][2 * i + 1] * rstd * gb; s2 += y[j][2 * i] * y[j][2 * i] + y[j][2 * i + 1] * y[j][2 * i + 1]; } }
        if (final_) {
            float* orow = p.out + (size_t)r * DM;
#pragma unroll
            for (int j = 0; j < 4; ++j) { const int col = (c.lane + 64 * j) * 8; __builtin_nontemporal_store((f32x4){y[j][0], y[j][1], y[j][2], y[j][3]}, (f32x4*)(orow + col)); __builtin_nontemporal_store((f32x4){y[j][4], y[j][5], y[j][6], y[j][7]}, (f32x4*)(orow + col + 4)); }
        } else {
            u32x4 hb[4]; float s2b = 0.f;
#pragma unroll
            for (int j = 0; j < 4; ++j) { hb[j] = (u32x4){pk2(y[j][0], y[j][1]), pk2(y[j][2], y[j][3]), pk2(y[j][4], y[j][5]), pk2(y[j][6], y[j][7])}; const unsigned hw[4] = {hb[j].x, hb[j].y, hb[j].z, hb[j].w};
#pragma unroll
                for (int i = 0; i < 4; ++i) s2b += bflo(hw[i]) * bflo(hw[i]) + bfhi(hw[i]) * bfhi(hw[i]); hrow[c.lane + 64 * j] = hb[j]; }
            const float rstd2 = 1.0f / sqrtf(wave_sum(s2b) * (1.0f / DM) + EPS);
            if (c.lane == 0) ((float*)(c.ws + WS_RS))[r] = rstd2;
        }
    }
}

__device__ __forceinline__ void hgrn_scan_simple(const Params& p, const Ctx& c, int hd) {
    const bf16_t* proj = (const bf16_t*)(c.ws + WS_BIG + B_PROJ); float* HO = (float*)(c.ws + WS_BIG + B_HO);
    LAS float* sf = (LAS float*)c.lds; LAS float* sk = sf + 2048; LAS float* sq = sk + 2048; LAS float* sv = sq + 2048;
    const int v = c.tid >> 2, kq = c.tid & 3, lt = c.tid >> 5, lc = (c.tid & 31) * 4;
    float lbv[4];
#pragma unroll
    for (int i = 0; i < 4; ++i) { const int ch = hd * 128 + lc + i; const float l0 = p.in[I_LB][ch], l1 = p.in[I_LB][1024 + ch]; lbv[i] = 1.0f / (1.0f + __expf(l1 - l0)); }
    float S[32];
#pragma unroll
    for (int i = 0; i < 32; ++i) S[i] = 0.f;
    for (int t0 = 0; t0 < NTOK; t0 += 16) {
        __syncthreads();
        { const int row = row_of(t0 + lt); const bf16_t* pr = proj + (size_t)row * N_AB + hd * 128 + lc;
          const u32x2 qv = *(const u32x2*)pr, fv = *(const u32x2*)(pr + 1024), vv = *(const u32x2*)(pr + 2048);
          const float q4[4] = {bflo(qv.x), bfhi(qv.x), bflo(qv.y), bfhi(qv.y)}, f4[4] = {bflo(fv.x), bfhi(fv.x), bflo(fv.y), bfhi(fv.y)}, v4[4] = {bflo(vv.x), bfhi(vv.x), bflo(vv.y), bfhi(vv.y)};
#pragma unroll
          for (int i = 0; i < 4; ++i) { const float f = lbv[i] + (1.0f - lbv[i]) * sigmoidf_(f4[i]); const int o = lt * 128 + lc + i; sf[o] = f; sk[o] = 1.0f - f; sq[o] = q4[i]; sv[o] = v4[i]; } }
        __syncthreads();
        for (int tt = 0; tt < 16; ++tt) {
            const float vv = sv[tt * 128 + v]; float o = 0.f;
            const LAS f32x4* f4p = (const LAS f32x4*)(sf + tt * 128 + kq * 32); const LAS f32x4* k4p = (const LAS f32x4*)(sk + tt * 128 + kq * 32); const LAS f32x4* q4p = (const LAS f32x4*)(sq + tt * 128 + kq * 32);
#pragma unroll
            for (int i4 = 0; i4 < 8; ++i4) { const f32x4 ff = f4p[i4], kk = k4p[i4], qq = q4p[i4];
#pragma unroll
                for (int j = 0; j < 4; ++j) { S[i4 * 4 + j] = ff[j] * S[i4 * 4 + j] + kk[j] * vv; o += qq[j] * S[i4 * 4 + j]; } }
            o += __shfl_xor(o, 1); o += __shfl_xor(o, 2);
            if (kq == 0) HO[(size_t)row_of(t0 + tt) * 1024 + hd * 128 + v] = o;
        }
    }
}
constexpr int HG_NSC = 33;
constexpr size_t B_HL = B_Y;
constexpr size_t B_HD = B_HL + (size_t)HG_NSC * 8 * 16384 * 4;
template <bool OUT>
__device__ __forceinline__ void hgrn_item(const Params& p, const Ctx& c, int hd, int sc) {
    const bf16_t* proj = (const bf16_t*)(c.ws + WS_BIG + B_PROJ); float* HL = (float*)(c.ws + WS_BIG + B_HL); float* HD = (float*)(c.ws + WS_BIG + B_HD); bf16_t* MO = (bf16_t*)(c.ws + WS_HN);
    LAS bf16_t* Qs = (LAS bf16_t*)c.lds; LAS bf16_t* Ks = Qs + 32 * 136; LAS bf16_t* KeT = Ks + 32 * 136; LAS bf16_t* VT = KeT + 128 * 40; LAS bf16_t* ST = VT + 128 * 40;
    LAS float* dec = (LAS float*)(ST + 128 * 136); LAS bf16_t* Pw = (LAS bf16_t*)(dec + 128) + c.wave * (32 * 40); LAS float* Ot = (LAS float*)((LAS bf16_t*)(dec + 128) + 8 * 32 * 40);
    const int w = c.wave, l = c.lane, n = l & 15, g = l >> 4, j = l & 31, d0 = 8 * (2 * w + (l >> 5));
    float lb[8], omlb[8];
#pragma unroll
    for (int i = 0; i < 8; ++i) { const int ch = hd * 128 + d0 + i; lb[i] = 1.0f / (1.0f + __expf(p.in[I_LB][1024 + ch] - p.in[I_LB][ch])); omlb[i] = 1.0f - lb[i]; }
    const int nss = sc == 0 ? 1 : 8;
    const size_t sbase = (size_t)(sc * 8 + hd) * 16384;
    f32x4 acc[8];
#pragma unroll
    for (int kt = 0; kt < 8; ++kt) {
        if (OUT) {
#pragma unroll
            for (int r = 0; r < 4; ++r) { const float s = HL[sbase + (size_t)(16 * w + 4 * g + r) * 128 + 16 * kt + n]; acc[kt][r] = s; ST[(16 * w + 4 * g + r) * 136 + 16 * kt + n] = (bf16_t)f2bf(s); }
        } else acc[kt] = (f32x4){0.f, 0.f, 0.f, 0.f};
    }
    float btot[8];
#pragma unroll
    for (int i = 0; i < 8; ++i) btot[i] = 0.f;
    u32x4 rq, rf, rv;
    { const int row = sc == 0 ? NREAL + (j & 15) : (sc - 1) * 256 + j; const bf16_t* pr = proj + (size_t)row * N_AB + hd * 128 + d0; rq = *(const u32x4*)pr; rf = *(const u32x4*)(pr + 1024); rv = *(const u32x4*)(pr + 2048); }
    for (int ss = 0; ss < nss; ++ss) {
        LAS bf16_t* const KeTc = (!OUT && (ss & 1)) ? (LAS bf16_t*)(dec + 128) : KeT; LAS bf16_t* const VTc = (!OUT && (ss & 1)) ? (LAS bf16_t*)(dec + 128) + 128 * 40 : VT; LAS float* const decc = (!OUT && (ss & 1)) ? Ot : dec;
        if (sc == 0 && j >= 16) { rq = (u32x4){0u, 0u, 0u, 0u}; rv = rq; rf = (u32x4){0x43004300u, 0x43004300u, 0x43004300u, 0x43004300u}; }
        float q[8] = {bflo(rq.x), bfhi(rq.x), bflo(rq.y), bfhi(rq.y), bflo(rq.z), bfhi(rq.z), bflo(rq.w), bfhi(rq.w)};
        float fl[8] = {bflo(rf.x), bfhi(rf.x), bflo(rf.y), bfhi(rf.y), bflo(rf.z), bfhi(rf.z), bflo(rf.w), bfhi(rf.w)};
        const u32x4 rv0 = rv;
        if (ss + 1 < nss) { const int row = (sc - 1) * 256 + (ss + 1) * 32 + j; const bf16_t* pr = proj + (size_t)row * N_AB + hd * 128 + d0; rq = *(const u32x4*)pr; rf = *(const u32x4*)(pr + 1024); rv = *(const u32x4*)(pr + 2048); }
        float k[8], b[8];
#pragma unroll
        for (int i = 0; i < 8; ++i) { const float f = lb[i] + omlb[i] * sigmoidf_(fl[i]); k[i] = 1.0f - f; b[i] = 0.6931471805599453f * __builtin_amdgcn_logf(f); }
#pragma unroll
        for (int i = 0; i < 8; ++i) b[i] = scan32_incl(b[i]);
        float qs[8], ks[8], ke[8], b31v[8];
#pragma unroll
        for (int i = 0; i < 8; ++i) { const float b31 = __shfl(b[i], 31, 32);
            qs[i] = q[i] * __expf(b[i]); ks[i] = k[i] * __expf(fminf(-b[i], 80.f)); ke[i] = k[i] * __expf(b31 - b[i]);
            b31v[i] = b31; btot[i] += b31; }
        { const unsigned rvw[4] = {rv0.x, rv0.y, rv0.z, rv0.w};
#pragma unroll
          for (int i = 0; i < 8; i += 2) { const unsigned kw = pk2(ke[i], ke[i + 1]);
            KeTc[(d0 + i) * 40 + j] = (bf16_t)(kw & 0xffffu); KeTc[(d0 + i + 1) * 40 + j] = (bf16_t)(kw >> 16);
            VTc[(d0 + i) * 40 + j] = (bf16_t)(rvw[i >> 1] & 0xffffu); VTc[(d0 + i + 1) * 40 + j] = (bf16_t)(rvw[i >> 1] >> 16); } }
        if (j == 31) { *(LAS f32x4*)(decc + d0) = (f32x4){__expf(b31v[0]), __expf(b31v[1]), __expf(b31v[2]), __expf(b31v[3])}; *(LAS f32x4*)(decc + d0 + 4) = (f32x4){__expf(b31v[4]), __expf(b31v[5]), __expf(b31v[6]), __expf(b31v[7])}; }
        if (OUT) { *(LAS u32x4*)(Qs + j * 136 + d0) = (u32x4){pk2(qs[0], qs[1]), pk2(qs[2], qs[3]), pk2(qs[4], qs[5]), pk2(qs[6], qs[7])};
                   *(LAS u32x4*)(Ks + j * 136 + d0) = (u32x4){pk2(ks[0], ks[1]), pk2(ks[2], ks[3]), pk2(ks[4], ks[5]), pk2(ks[6], ks[7])}; }
        u32x4 gtp = (u32x4){0u, 0u, 0u, 0u};
        if (OUT) { const int tt_ = c.tid >> 4, v0_ = (c.tid & 15) * 8; const int row_ = sc == 0 ? NREAL + (tt_ & 15) : (sc - 1) * 256 + ss * 32 + tt_; gtp = *(const u32x4*)(proj + (size_t)row_ * N_AB + 3072 + hd * 128 + v0_); }
        __syncthreads();
        const bf16x8 vt = *(const LAS bf16x8*)(VTc + (16 * w + n) * 40 + 8 * g);
        if (OUT) {
            bf16x8 aq[2][4];
#pragma unroll
            for (int mt = 0; mt < 2; ++mt)
#pragma unroll
                for (int s = 0; s < 4; ++s) aq[mt][s] = *(const LAS bf16x8*)(Qs + (16 * mt + n) * 136 + 32 * s + 8 * g);
            f32x4 o[2] = {(f32x4){0.f, 0.f, 0.f, 0.f}, (f32x4){0.f, 0.f, 0.f, 0.f}};
#pragma unroll
            for (int s = 0; s < 4; ++s) { const bf16x8 bs = *(const LAS bf16x8*)(ST + (16 * w + n) * 136 + 32 * s + 8 * g);
                o[0] = __builtin_amdgcn_mfma_f32_16x16x32_bf16(aq[0][s], bs, o[0], 0, 0, 0); o[1] = __builtin_amdgcn_mfma_f32_16x16x32_bf16(aq[1][s], bs, o[1], 0, 0, 0); }
            f32x4 pp[2][2];
#pragma unroll
            for (int mt = 0; mt < 2; ++mt)
#pragma unroll
                for (int nt = 0; nt < 2; ++nt) pp[mt][nt] = (f32x4){0.f, 0.f, 0.f, 0.f};
#pragma unroll
            for (int nt = 0; nt < 2; ++nt)
#pragma unroll
                for (int s = 0; s < 4; ++s) { const bf16x8 bk = *(const LAS bf16x8*)(Ks + (16 * nt + n) * 136 + 32 * s + 8 * g);
                    pp[0][nt] = __builtin_amdgcn_mfma_f32_16x16x32_bf16(aq[0][s], bk, pp[0][nt], 0, 0, 0); pp[1][nt] = __builtin_amdgcn_mfma_f32_16x16x32_bf16(aq[1][s], bk, pp[1][nt], 0, 0, 0); }
#pragma unroll
            for (int mt = 0; mt < 2; ++mt)
#pragma unroll
                for (int nt = 0; nt < 2; ++nt)
#pragma unroll
                    for (int r = 0; r < 4; r += 2) { const int ii = 16 * mt + 4 * g + r, jj = 16 * nt + n; const unsigned pw_ = pk2(jj <= ii ? pp[mt][nt][r] : 0.f, jj <= ii + 1 ? pp[mt][nt][r + 1] : 0.f);
                        Pw[ii * 40 + jj] = (bf16_t)(pw_ & 0xffffu); Pw[(ii + 1) * 40 + jj] = (bf16_t)(pw_ >> 16); }
            LDS_WAIT();
#pragma unroll
            for (int mt = 0; mt < 2; ++mt) { const bf16x8 pa = *(const LAS bf16x8*)(Pw + (16 * mt + n) * 40 + 8 * g); o[mt] = __builtin_amdgcn_mfma_f32_16x16x32_bf16(pa, vt, o[mt], 0, 0, 0); }
#pragma unroll
            for (int mt = 0; mt < 2; ++mt)
#pragma unroll
                for (int r = 0; r < 4; ++r) Ot[(16 * mt + 4 * g + r) * 132 + 16 * w + n] = o[mt][r];
        }
#pragma unroll
        for (int kt = 0; kt < 8; ++kt) { const float dk = decc[16 * kt + n]; const bf16x8 bke = *(const LAS bf16x8*)(KeTc + (16 * kt + n) * 40 + 8 * g);
            acc[kt] = acc[kt] * dk; acc[kt] = __builtin_amdgcn_mfma_f32_16x16x32_bf16(vt, bke, acc[kt], 0, 0, 0); }
        if (OUT && ss + 1 < nss) {
#pragma unroll
            for (int kt = 0; kt < 8; ++kt)
#pragma unroll
                for (int r = 0; r < 4; r += 2) { const unsigned pw_ = pk2(acc[kt][r], acc[kt][r + 1]); ST[(16 * w + 4 * g + r) * 136 + 16 * kt + n] = (bf16_t)(pw_ & 0xffffu); ST[(16 * w + 4 * g + r + 1) * 136 + 16 * kt + n] = (bf16_t)(pw_ >> 16); }
        }
        if (OUT) __syncthreads();
        if (OUT) {
            const int tt = c.tid >> 4, v0 = (c.tid & 15) * 8;
            const f32x4 x0 = *(const LAS f32x4*)(Ot + tt * 132 + v0), x1 = *(const LAS f32x4*)(Ot + tt * 132 + v0 + 4);
            float ssq = x0[0] * x0[0] + x0[1] * x0[1] + x0[2] * x0[2] + x0[3] * x0[3] + x1[0] * x1[0] + x1[1] * x1[1] + x1[2] * x1[2] + x1[3] * x1[3];
            ssq = row16_sum(ssq);
            const float rstd = __builtin_amdgcn_rsqf(ssq * (1.0f / 128.0f) + EPS);
            if (sc != 0 || tt < 16) {
                const int row = sc == 0 ? NREAL + tt : (sc - 1) * 256 + ss * 32 + tt;
                const u32x4 gt = gtp; const f32x4 g0 = *(const f32x4*)(p.in[I_HG_NORM] + v0), g1 = *(const f32x4*)(p.in[I_HG_NORM] + v0 + 4);
                u32x4 ov; ov.x = pk2(x0[0] * rstd * g0[0] * siluf_(bflo(gt.x)), x0[1] * rstd * g0[1] * siluf_(bfhi(gt.x))); ov.y = pk2(x0[2] * rstd * g0[2] * siluf_(bflo(gt.y)), x0[3] * rstd * g0[3] * siluf_(bfhi(gt.y)));
                ov.z = pk2(x1[0] * rstd * g1[0] * siluf_(bflo(gt.z)), x1[1] * rstd * g1[1] * siluf_(bfhi(gt.z))); ov.w = pk2(x1[2] * rstd * g1[2] * siluf_(bflo(gt.w)), x1[3] * rstd * g1[3] * siluf_(bfhi(gt.w)));
                *(u32x4*)(MO + (size_t)row * DM + hd * 128 + v0) = ov;
            }
        }
    }
    if (!OUT) {
#pragma unroll
        for (int kt = 0; kt < 8; ++kt)
#pragma unroll
            for (int r = 0; r < 4; ++r) HL[sbase + (size_t)(16 * w + 4 * g + r) * 128 + 16 * kt + n] = acc[kt][r];
        if (j == 31) {
#pragma unroll
            for (int i = 0; i < 8; ++i) HD[(size_t)(sc * 8 + hd) * 128 + d0 + i] = __expf(btot[i]); }
    }
    __syncthreads();
}
template <bool OUT>
__device__ __forceinline__ void phase_hgrn(const Params& p, const Ctx& c) {
    for (int it = c.b; it < HG_NSC * 8; it += c.G) { const int hd = it & 7, sc = it < 256 ? 1 + (it >> 3) : 0; hgrn_item<OUT>(p, c, hd, sc); }
}
__device__ __forceinline__ void phase_hgrn_scan(const Params& p, const Ctx& c) {
    float* HL = (float*)(c.ws + WS_BIG + B_HL); const float* HD = (const float*)(c.ws + WS_BIG + B_HD);
    for (int gid = c.b * NTHR + c.tid; gid < 8 * 16384; gid += c.G * NTHR) {
        const int hd = gid >> 14, rem = gid & 16383, kd = rem & 127; float S = 0.f;
        for (int s0 = 0; s0 < HG_NSC; s0 += 11) { float lv[11], dv[11];
#pragma unroll
            for (int k = 0; k < 11; ++k) { lv[k] = HL[(size_t)((s0 + k) * 8 + hd) * 16384 + rem]; dv[k] = HD[(size_t)((s0 + k) * 8 + hd) * 128 + kd]; }
#pragma unroll
            for (int k = 0; k < 11; ++k) { HL[(size_t)((s0 + k) * 8 + hd) * 16384 + rem] = S; S = dv[k] * S + lv[k]; } }
    }
}

__device__ __forceinline__ void sconv_part(const Params& p, const Ctx& c, int b0, int nb) {
    const bf16_t* proj = (const bf16_t*)(c.ws + WS_BIG + B_PROJ); bf16_t* MO = (bf16_t*)(c.ws + WS_HN); const float* w = p.in[I_SCONV];
    const int stride = nb * NTHR, total = NTOK * 256;
    for (int idx0 = (c.b - b0) * NTHR + c.tid; idx0 < total; idx0 += 4 * stride) {
        u32x2 sx[4][3], sc[4][3], sb[4];
#pragma unroll
        for (int u = 0; u < 4; ++u) { const int idx = min(idx0 + u * stride, total - 1), t = idx >> 8, c4 = (idx & 255) * 4;
#pragma unroll
            for (int j = 0; j < 3; ++j) { const int tp = max(t - 2 + j, 0); const bf16_t* pr = proj + (size_t)row_of(tp) * N_AB; sx[u][j] = *(const u32x2*)(pr + 4096 + c4); sc[u][j] = *(const u32x2*)(pr + 6144 + c4); }
            sb[u] = *(const u32x2*)(proj + (size_t)row_of(t) * N_AB + 5120 + c4); }
#pragma unroll
        for (int u = 0; u < 4; ++u) { const int idx = idx0 + u * stride; if (idx >= total) break; const int t = idx >> 8, c4 = (idx & 255) * 4; float acc[4] = {0.f, 0.f, 0.f, 0.f};
#pragma unroll
            for (int j = 0; j < 3; ++j) { if (t - 2 + j < 0) continue; const f32x4 wv = *(const f32x4*)(w + j * 1024 + c4);
                acc[0] += wv[0] * bflo(sx[u][j].x) * bflo(sc[u][j].x); acc[1] += wv[1] * bfhi(sx[u][j].x) * bfhi(sc[u][j].x); acc[2] += wv[2] * bflo(sx[u][j].y) * bflo(sc[u][j].y); acc[3] += wv[3] * bfhi(sx[u][j].y) * bfhi(sc[u][j].y); }
            *(u32x2*)(MO + (size_t)row_of(t) * DM + 1024 + c4) = (u32x2){pk2(acc[0] * bflo(sb[u].x), acc[1] * bfhi(sb[u].x)), pk2(acc[2] * bflo(sb[u].y), acc[3] * bfhi(sb[u].y))}; }
    }
}
__device__ __forceinline__ void phase_hgrn_out(const Params& p, const Ctx& c) {
    const bf16_t* proj = (const bf16_t*)(c.ws + WS_BIG + B_PROJ); const float* HO = (const float*)(c.ws + WS_BIG + B_HO); bf16_t* MO = (bf16_t*)(c.ws + WS_HN); const float* g = p.in[I_HG_NORM];
    for (int it = c.b * NWAVES + c.wave; it < NTOK * 8; it += c.G * NWAVES) {
        const int row = it >> 3, hd = it & 7, ch = hd * 128 + 2 * c.lane;
        const f32x2 o = *(const f32x2*)(HO + (size_t)row * 1024 + ch);
        const float rstd = 1.0f / sqrtf(wave_sum(o[0] * o[0] + o[1] * o[1]) * (1.0f / 128.0f) + EPS);
        const unsigned gt = *(const unsigned*)(proj + (size_t)row * N_AB + 3072 + ch);
        *(unsigned*)(MO + (size_t)row * DM + ch) = pk2(o[0] * rstd * g[2 * c.lane] * siluf_(bflo(gt)), o[1] * rstd * g[2 * c.lane + 1] * siluf_(bfhi(gt)));
    }
}

__device__ __forceinline__ void rg_u_part(const Params& p, const Ctx& c) {
    const bf16_t* proj = (const bf16_t*)(c.ws + WS_BIG + B_PROJ); float* U = (float*)(c.ws + WS_BIG + B_U); const float* w = p.in[I_RG_CW]; const float* bb = p.in[I_RG_CB];
    for (int idx = c.b * NTHR + c.tid; idx < NTOK * 256; idx += c.G * NTHR) {
        const int t = idx >> 8, c4 = (idx & 255) * 4; f32x4 acc = *(const f32x4*)(bb + c4);
#pragma unroll
        for (int j = 0; j < 4; ++j) { const int tp = t - 3 + j; if (tp < 0) continue; const u32x2 rx = *(const u32x2*)(proj + (size_t)row_of(tp) * N_CDP + c4); const f32x4 wv = *(const f32x4*)(w + j * 1024 + c4);
            acc[0] += wv[0] * bflo(rx.x); acc[1] += wv[1] * bfhi(rx.x); acc[2] += wv[2] * bflo(rx.y); acc[3] += wv[3] * bfhi(rx.y); }
        *(f32x4*)(U + (size_t)row_of(t) * 1024 + c4) = acc;
    }
}
__device__ __forceinline__ void dsa_c_part(const Params& p, const Ctx& c) {
    const bf16_t* proj = (const bf16_t*)(c.ws + WS_BIG + B_PROJ); bf16_t* C = (bf16_t*)(c.ws + WS_C); const float* g = p.in[I_KVN];
    const int stride = c.G * NWAVES;
    for (int rb = c.b * NWAVES + c.wave; rb < NTOK; rb += 4 * stride) {
        u32x2 vv[4];
#pragma unroll
        for (int k = 0; k < 4; ++k) vv[k] = *(const u32x2*)(proj + (size_t)min(rb + k * stride, NTOK - 1) * N_CDP + 3072 + 4 * c.lane);
        const f32x4 gg = *(const f32x4*)(g + 4 * c.lane);
#pragma unroll
        for (int k = 0; k < 4; ++k) { const int r = rb + k * stride; if (r >= NTOK) continue;
            const u32x2 v = vv[k]; const float a0 = bflo(v.x), a1 = bfhi(v.x), a2 = bflo(v.y), a3 = bfhi(v.y);
            const float rstd = 1.0f / sqrtf(wave_sum(a0 * a0 + a1 * a1 + a2 * a2 + a3 * a3) * (1.0f / 256.0f) + EPS);
            const float c0 = fminf(fmaxf(a0 * rstd * gg[0], -448.f), 448.f), c1 = fminf(fmaxf(a1 * rstd * gg[1], -448.f), 448.f), c2 = fminf(fmaxf(a2 * rstd * gg[2], -448.f), 448.f), c3 = fminf(fmaxf(a3 * rstd * gg[3], -448.f), 448.f);
            int pk = __builtin_amdgcn_cvt_pk_fp8_f32(c0, c1, 0, false); pk = __builtin_amdgcn_cvt_pk_fp8_f32(c2, c3, pk, true);
            ((unsigned*)C)[(size_t)r * 64 + c.lane] = (unsigned)pk; }
    }
}
__device__ __forceinline__ void phase_rg_gates(const Params& p, const Ctx& c) {
    const float* U = (const float*)(c.ws + WS_BIG + B_U); float* A = (float*)(c.ws + WS_BIG + B_A); float* X = (float*)(c.ws + WS_BIG + B_X);
    LAS float* su = (LAS float*)c.lds;
    const int sub = c.tid >> 7, d = c.tid & 127; constexpr int NT64 = (NTOK + 63) / 64;
    for (int it = c.b; it < NT64 * 8; it += c.G) {
        const int tile = it >> 3, n = it & 7, t0 = tile * 64;
        __syncthreads();
        for (int i = c.tid; i < 64 * 32; i += NTHR) { const int tk = i >> 5, c4 = (i & 31) * 4; const int t = t0 + tk;
            const f32x4 v = t < NTOK ? *(const f32x4*)(U + (size_t)row_of(t) * 1024 + n * 128 + c4) : (f32x4){0.f, 0.f, 0.f, 0.f}; *(LAS f32x4*)(su + tk * 128 + c4) = v; }
        __syncthreads();
        float aa[16], ai[16];
#pragma unroll
        for (int k = 0; k < 16; ++k) { aa[k] = 0.f; ai[k] = 0.f; }
        const float* wa = p.in[I_RG_WA] + (size_t)n * 16384 + d; const float* wi = p.in[I_RG_WI] + (size_t)n * 16384 + d;
        for (int cc = 0; cc < 128; cc += 4) {
            float wav[4], wiv[4];
#pragma unroll
            for (int j = 0; j < 4; ++j) { wav[j] = wa[(cc + j) * 128]; wiv[j] = wi[(cc + j) * 128]; }
#pragma unroll
            for (int k = 0; k < 16; ++k) { const f32x4 u4 = *(const LAS f32x4*)(su + (sub * 16 + k) * 128 + cc);
#pragma unroll
                for (int j = 0; j < 4; ++j) { aa[k] += u4[j] * wav[j]; ai[k] += u4[j] * wiv[j]; } }
        }
        const int ch = n * 128 + d; const float ba = p.in[I_RG_BA][ch], bi = p.in[I_RG_BI][ch], lam = p.in[I_RG_LAM][ch];
        const float sp = log1pf(__expf(-lam));
#pragma unroll
        for (int k = 0; k < 16; ++k) { const int t = t0 + sub * 16 + k; if (t >= NTOK) continue; const size_t o = (size_t)row_of(t) * 1024 + ch;
            const float r = sigmoidf_(aa[k] + ba), ig = sigmoidf_(ai[k] + bi), la = -8.0f * r * sp;
            A[o] = __expf(la); X[o] = sqrtf(-expm1f(2.0f * la)) * ig * su[(sub * 16 + k) * 128 + d]; }
    }
}
__device__ __forceinline__ void rg_scan_simple(const Params& p, const Ctx& c) {
    const bf16_t* proj = (const bf16_t*)(c.ws + WS_BIG + B_PROJ); const float* A = (const float*)(c.ws + WS_BIG + B_A); const float* X = (const float*)(c.ws + WS_BIG + B_X); bf16_t* MO = (bf16_t*)(c.ws + WS_HN);
    const int ch = c.b * NTHR + c.tid; if (ch >= 1024) return;
    float hs = 0.f;
    for (int t0 = 0; t0 < NTOK; t0 += 16) {
        float a[16], x[16], g[16];
#pragma unroll
        for (int k = 0; k < 16; ++k) { const int row = row_of(t0 + k); a[k] = A[(size_t)row * 1024 + ch]; x[k] = X[(size_t)row * 1024 + ch]; g[k] = bf2f(proj[(size_t)row * N_CDP + 1024 + ch]); }
#pragma unroll
        for (int k = 0; k < 16; ++k) { hs = a[k] * hs + x[k]; MO[(size_t)row_of(t0 + k) * DM + ch] = (bf16_t)f2bf(hs * gelu_tanh(g[k])); }
    }
}

__device__ __forceinline__ size_t sc_off(int q) { const size_t i = (size_t)(q >> 7); return (size_t)16384 * (i * (i + 1) / 2) + (size_t)(q & 127) * ((i + 1) * 128); }
template <int MODE>
__device__ __forceinline__ void bd_gemm(const Params& p, const Ctx& c) {
    constexpr int K = MODE == 1 ? 256 : 128, N = MODE == 1 ? 128 : 256, KP = K + 8, NS = K / 32;
    const bf16_t* proj = (const bf16_t*)(c.ws + WS_BIG + B_PROJ);
    LAS bf16_t* WT = (LAS bf16_t*)c.lds;
    const int ng = c.G >> 3, gidx = c.b & 7, tb = c.b >> 3; if (tb >= ng) return;
    if (MODE == 0) { const float* w = p.in[I_WUK] + gidx * 128;
        for (int i = c.tid; i < 256 * 16; i += NTHR) { const int r = i >> 4, ch = (i & 15) * 8; const f32x4 a = *(const f32x4*)(w + (size_t)r * 1024 + ch), b = *(const f32x4*)(w + (size_t)r * 1024 + ch + 4);
            *(LAS u32x4*)(WT + r * KP + ch) = (u32x4){pk2(a[0], a[1]), pk2(a[2], a[3]), pk2(b[0], b[1]), pk2(b[2], b[3])}; } }
    if (MODE == 1) { const float* w = p.in[I_WUV] + gidx * 128;
        for (int i = c.tid; i < 128 * 32; i += NTHR) { const int r = (i & 127) * 2, d4 = (i >> 7) * 4; const f32x4 a0 = *(const f32x4*)(w + (size_t)r * 1024 + d4), a1 = *(const f32x4*)(w + (size_t)(r + 1) * 1024 + d4);
#pragma unroll
            for (int q = 0; q < 4; ++q) *(LAS unsigned*)(WT + (d4 + q) * KP + r) = pk2(a0[q], a1[q]); } }
    if (MODE == 2) {
        for (int i = c.tid; i < 2 * 128 * 32; i += NTHR) { const int m = i >> 12, cc = (i >> 5) & 127, d4 = (i & 31) * 4; const f32x4 a = *(const f32x4*)((m ? p.in[I_RG_WI] : p.in[I_RG_WA]) + (size_t)gidx * 16384 + cc * 128 + d4);
#pragma unroll
            for (int q = 0; q < 4; ++q) WT[(m * 128 + d4 + q) * KP + cc] = (bf16_t)f2bf(a[q]); } }
    __syncthreads();
    const int n = c.lane & 15, g = c.lane >> 4, rs = c.wave & 3, hf = c.wave >> 2;
    constexpr int NT64 = (NTOK + 63) / 64;
    auto ldaf = [&](bf16x8 (&dst)[NS], const int tile_) __attribute__((always_inline)) {
        const int t_ = min(tile_, NT64 - 1) * 64 + 16 * rs + n; const int tc_ = t_ < NTOK ? t_ : NTOK - 1;
        if (MODE == 0) {
#pragma unroll
            for (int s = 0; s < NS; ++s) dst[s] = *(const bf16x8*)(proj + (size_t)tc_ * N_CDP + 2048 + gidx * 128 + 32 * s + 8 * g); }
        if (MODE == 1) { const bf16_t* OL = (const bf16_t*)(c.ws + WS_QL);
#pragma unroll
            for (int s = 0; s < NS; ++s) dst[s] = *(const bf16x8*)(OL + (size_t)tc_ * DM + gidx * 256 + 32 * s + 8 * g); } };
    bf16x8 afn[NS];
    if (MODE != 2) ldaf(afn, tb);
    for (int tile = tb; tile < NT64; tile += ng) {
        const int t = tile * 64 + 16 * rs + n;
        const int tc = t < NTOK ? t : NTOK - 1;
        bf16x8 af[NS];
        if (MODE != 2) {
#pragma unroll
            for (int s = 0; s < NS; ++s) af[s] = afn[s];
            ldaf(afn, tile + ng); }
        if (MODE == 2) {
#pragma unroll
            for (int s = 0; s < NS; ++s) { const int c0 = gidx * 128 + 32 * s + 8 * g; f32x4 u0 = *(const f32x4*)(p.in[I_RG_CB] + c0), u1 = *(const f32x4*)(p.in[I_RG_CB] + c0 + 4);
#pragma unroll
                for (int jj = 0; jj < 4; ++jj) { const int tp = tc - 3 + jj; if (tp < 0) continue; const u32x4 rx = *(const u32x4*)(proj + (size_t)row_of(tp) * N_CDP + c0);
                    const f32x4 w0 = *(const f32x4*)(p.in[I_RG_CW] + jj * 1024 + c0), w1 = *(const f32x4*)(p.in[I_RG_CW] + jj * 1024 + c0 + 4);
                    u0[0] += w0[0] * bflo(rx.x); u0[1] += w0[1] * bfhi(rx.x); u0[2] += w0[2] * bflo(rx.y); u0[3] += w0[3] * bfhi(rx.y); u1[0] += w1[0] * bflo(rx.z); u1[1] += w1[1] * bfhi(rx.z); u1[2] += w1[2] * bflo(rx.w); u1[3] += w1[3] * bfhi(rx.w); }
                const u32x4 pk = (u32x4){pk2(u0[0], u0[1]), pk2(u0[2], u0[3]), pk2(u1[0], u1[1]), pk2(u1[2], u1[3])}; af[s] = __builtin_bit_cast(bf16x8, pk); asm volatile("" ::: "memory"); } }
        constexpr int NTL = MODE == 0 ? 8 : 4;
#pragma unroll
        for (int i = 0; i < NTL; ++i) {
            const int nt = hf * NTL + i;
            f32x4 acc = (f32x4){0.f, 0.f, 0.f, 0.f}, acc2 = (f32x4){0.f, 0.f, 0.f, 0.f};
#pragma unroll
            for (int s = 0; s < NS; ++s) { const bf16x8 wf = *(const LAS bf16x8*)(WT + (16 * nt + n) * KP + 32 * s + 8 * g); acc = __builtin_amdgcn_mfma_f32_16x16x32_bf16(wf, af[s], acc, 0, 0, 0);
                if (MODE == 2) { const bf16x8 wf2 = *(const LAS bf16x8*)(WT + (128 + 16 * nt + n) * KP + 32 * s + 8 * g); acc2 = __builtin_amdgcn_mfma_f32_16x16x32_bf16(wf2, af[s], acc2, 0, 0, 0); } }
            if (t < NTOK) {
                const int col = 16 * nt + 4 * g;
                if (MODE == 0) { bf16_t* QL = (bf16_t*)(c.ws + WS_QL); const float sc = 0.08838834764831845f;
                    *(u32x2*)(QL + (size_t)t * DM + gidx * 256 + col) = (u32x2){pk2(acc[0] * sc, acc[1] * sc), pk2(acc[2] * sc, acc[3] * sc)}; }
                if (MODE == 1) { bf16_t* MO = (bf16_t*)(c.ws + WS_HN); *(u32x2*)(MO + (size_t)t * DM + 1024 + gidx * 128 + col) = (u32x2){pk2(acc[0], acc[1]), pk2(acc[2], acc[3])}; }
                if (MODE == 2) { float* A = (float*)(c.ws + WS_BIG + B_A); float* X = (float*)(c.ws + WS_BIG + B_X); const int ch = gidx * 128 + col;
                    f32x4 u = *(const f32x4*)(p.in[I_RG_CB] + ch);
#pragma unroll
                    for (int jj = 0; jj < 4; ++jj) { const int tp = t - 3 + jj; if (tp < 0) continue; const u32x2 rx = *(const u32x2*)(proj + (size_t)row_of(tp) * N_CDP + ch); const f32x4 w0 = *(const f32x4*)(p.in[I_RG_CW] + jj * 1024 + ch);
                        u[0] += w0[0] * bflo(rx.x); u[1] += w0[1] * bfhi(rx.x); u[2] += w0[2] * bflo(rx.y); u[3] += w0[3] * bfhi(rx.y); }
                    const f32x4 ba = *(const f32x4*)(p.in[I_RG_BA] + ch), bi = *(const f32x4*)(p.in[I_RG_BI] + ch), lam = *(const f32x4*)(p.in[I_RG_LAM] + ch);
                    f32x4 av, xv;
#pragma unroll
                    for (int r = 0; r < 4; ++r) { const float rg = sigmoidf_(acc[r] + ba[r]), ig = sigmoidf_(acc2[r] + bi[r]), la = -8.0f * rg * __logf(1.0f + __expf(-lam[r])); const float aa = __expf(la); av[r] = aa; xv[r] = __builtin_amdgcn_sqrtf(fmaxf(1.0f - aa * aa, 0.f)) * ig * u[r]; }
                    const size_t o = (size_t)row_of(t) * 1024 + ch; *(f32x4*)(A + o) = av; *(f32x4*)(X + o) = xv; }
            }
        }
    }
    __syncthreads();
}

__device__ __forceinline__ void phase_gates_v2(const Params& p, const Ctx& c) {
    constexpr int KP = 136;
    const bf16_t* proj = (const bf16_t*)(c.ws + WS_BIG + B_PROJ); bf16_t* MOg = (bf16_t*)(c.ws + WS_HN); float* SUM = (float*)(c.ws + WS_C + (size_t)ROWS * 256);
    LAS bf16_t* WT = (LAS bf16_t*)c.lds;
    LAS bf16_t* UB = WT + 256 * KP;
    LAS float* LA = (LAS float*)(UB + 64 * KP);
    LAS bf16_t* LX = (LAS bf16_t*)(LA + 64 * 132);
    LAS float* PS = (LAS float*)(LX + 64 * KP);
    const int ng = c.G >> 3, gidx = c.b & 7, tb = c.b >> 3; if (tb >= ng) return;
    for (int i = c.tid; i < 2 * 64 * 32; i += NTHR) { const int m = i >> 11, cc = (i & 63) * 2, d4 = ((i >> 6) & 31) * 4;
        const float* wsrc = (m ? p.in[I_RG_WI] : p.in[I_RG_WA]) + (size_t)gidx * 16384 + cc * 128 + d4; const f32x4 a0 = *(const f32x4*)wsrc, a1 = *(const f32x4*)(wsrc + 128);
#pragma unroll
        for (int q = 0; q < 4; ++q) *(LAS unsigned*)(WT + (m * 128 + d4 + q) * KP + cc) = pk2(a0[q], a1[q]); }
    const int tk = c.tid >> 3, cb = (c.tid & 7) * 16, ch0 = gidx * 128 + cb;
    LAS float* CW = PS + 4 * 128 * 2;
    for (int i = c.tid; i < 5 * 128; i += NTHR) { const int jj = i >> 7, cc = i & 127; CW[i] = jj < 4 ? p.in[I_RG_CW][jj * 1024 + gidx * 128 + cc] : p.in[I_RG_CB][gidx * 128 + cc]; }
    __syncthreads();
    const int n = c.lane & 15, g = c.lane >> 4, rs = c.wave & 3, hf = c.wave >> 2;
    f32x4 ba4[4], bi4[4], sp4[4];
#pragma unroll
    for (int i = 0; i < 4; ++i) { const int ch = gidx * 128 + 16 * (hf * 4 + i) + 4 * g; ba4[i] = *(const f32x4*)(p.in[I_RG_BA] + ch); bi4[i] = *(const f32x4*)(p.in[I_RG_BI] + ch); const f32x4 lam = *(const f32x4*)(p.in[I_RG_LAM] + ch);
#pragma unroll
        for (int r = 0; r < 4; ++r) sp4[i][r] = -8.0f * __logf(1.0f + __expf(-lam[r])); }
    constexpr int NT64 = (NTOK + 63) / 64;
    u32x4 rx[4][2];
    { const int t = min(tb * 64 + tk, NTOK - 1);
#pragma unroll
      for (int jj = 0; jj < 4; ++jj) { const int tp = t - 3 + jj; const bf16_t* s = proj + (size_t)row_of(tp < 0 ? 0 : tp) * N_CDP + ch0; rx[jj][0] = *(const u32x4*)s; rx[jj][1] = *(const u32x4*)(s + 8); } }
    for (int tile = tb; tile < NT64; tile += ng) {
        const int tq = tile * 64 + tk;
        float u[16];
#pragma unroll
        for (int i4 = 0; i4 < 4; ++i4) { const f32x4 bv = *(const LAS f32x4*)(CW + 4 * 128 + cb + 4 * i4); u[4 * i4] = bv[0]; u[4 * i4 + 1] = bv[1]; u[4 * i4 + 2] = bv[2]; u[4 * i4 + 3] = bv[3]; }
#pragma unroll
        for (int jj = 0; jj < 4; ++jj) { if (tq - 3 + jj < 0) continue;
            const unsigned wv[8] = {rx[jj][0].x, rx[jj][0].y, rx[jj][0].z, rx[jj][0].w, rx[jj][1].x, rx[jj][1].y, rx[jj][1].z, rx[jj][1].w};
#pragma unroll
            for (int i4 = 0; i4 < 4; ++i4) { const f32x4 wq = *(const LAS f32x4*)(CW + jj * 128 + cb + 4 * i4);
                u[4 * i4] += wq[0] * bflo(wv[2 * i4]); u[4 * i4 + 1] += wq[1] * bfhi(wv[2 * i4]); u[4 * i4 + 2] += wq[2] * bflo(wv[2 * i4 + 1]); u[4 * i4 + 3] += wq[3] * bfhi(wv[2 * i4 + 1]); } }
        __syncthreads();
        *(LAS u32x4*)(UB + tk * KP + cb) = (u32x4){pk2(u[0], u[1]), pk2(u[2], u[3]), pk2(u[4], u[5]), pk2(u[6], u[7])};
        *(LAS u32x4*)(UB + tk * KP + cb + 8) = (u32x4){pk2(u[8], u[9]), pk2(u[10], u[11]), pk2(u[12], u[13]), pk2(u[14], u[15])};
        if (tile + ng < NT64) { const int t = min((tile + ng) * 64 + tk, NTOK - 1);
#pragma unroll
            for (int jj = 0; jj < 4; ++jj) { const int tp = t - 3 + jj; const bf16_t* s = proj + (size_t)row_of(tp < 0 ? 0 : tp) * N_CDP + ch0; rx[jj][0] = *(const u32x4*)s; rx[jj][1] = *(const u32x4*)(s + 8); } }
        __syncthreads();
        const int t = tile * 64 + 16 * rs + n;
        bf16x8 af[4];
#pragma unroll
        for (int s = 0; s < 4; ++s) af[s] = *(const LAS bf16x8*)(UB + (16 * rs + n) * KP + 32 * s + 8 * g);
#pragma unroll
        for (int i = 0; i < 4; ++i) {
            const int nt = hf * 4 + i;
            f32x4 acc = (f32x4){0.f, 0.f, 0.f, 0.f}, acc2 = (f32x4){0.f, 0.f, 0.f, 0.f};
#pragma unroll
            for (int s = 0; s < 4; ++s) { const bf16x8 wf = *(const LAS bf16x8*)(WT + (16 * nt + n) * KP + 32 * s + 8 * g); acc = __builtin_amdgcn_mfma_f32_16x16x32_bf16(wf, af[s], acc, 0, 0, 0);
                const bf16x8 wf2 = *(const LAS bf16x8*)(WT + (128 + 16 * nt + n) * KP + 32 * s + 8 * g); acc2 = __builtin_amdgcn_mfma_f32_16x16x32_bf16(wf2, af[s], acc2, 0, 0, 0); }
            {
                const int col = 16 * nt + 4 * g; const u32x2 ub = *(const LAS u32x2*)(UB + (16 * rs + n) * KP + col); const float uu[4] = {bflo(ub.x), bfhi(ub.x), bflo(ub.y), bfhi(ub.y)};
                f32x4 lav, xv;
#pragma unroll
                for (int r = 0; r < 4; ++r) { const float rg = sigmoidf_(acc[r] + ba4[i][r]), ig = sigmoidf_(acc2[r] + bi4[i][r]); const float la = rg * sp4[i][r], aa = __expf(la);
                    lav[r] = t < NTOK ? la : 0.f; xv[r] = t < NTOK ? __builtin_amdgcn_sqrtf(fmaxf(1.0f - aa * aa, 0.f)) * ig * uu[r] : 0.f; }
                *(LAS f32x4*)(LA + (16 * rs + n) * 132 + col) = lav; *(LAS u32x2*)(LX + (16 * rs + n) * KP + col) = (u32x2){pk2(xv[0], xv[1]), pk2(xv[2], xv[3])};
            }
        }
        __syncthreads();
        { const int ch = c.tid & 127, part = c.tid >> 7, gch = gidx * 128 + ch;
          float lak[16], xk[16]; float h = 0.f, cl = 0.f;
#pragma unroll
          for (int k = 0; k < 16; ++k) { lak[k] = LA[(16 * part + k) * 132 + ch]; xk[k] = bf2f(LX[(16 * part + k) * KP + ch]); h = __expf(lak[k]) * h + xk[k]; cl += lak[k]; }
          PS[(part * 128 + ch) * 2] = h; PS[(part * 128 + ch) * 2 + 1] = cl;
          __syncthreads();
          float hin = 0.f, lin = 0.f;
#pragma unroll
          for (int pp = 0; pp < 3; ++pp) if (pp < part) { const float hp = PS[(pp * 128 + ch) * 2], lp = PS[(pp * 128 + ch) * 2 + 1]; hin = __expf(lp) * hin + hp; lin += lp; }
          h = hin; cl = lin;
#pragma unroll
          for (int k = 0; k < 16; ++k) { h = __expf(lak[k]) * h + xk[k]; cl += lak[k]; const int tt = tile * 64 + 16 * part + k;
              if (tt < NTOK) { const size_t o = (size_t)row_of(tt) * DM + gch; const unsigned pw_ = pk2(h, __expf(cl)); MOg[o + 1024] = (bf16_t)(pw_ & 0xffffu); MOg[o] = (bf16_t)(pw_ >> 16); } }
          if (part == 3) { SUM[(size_t)(tile * 2) * 1024 + gch] = __expf(cl); SUM[(size_t)(tile * 2 + 1) * 1024 + gch] = h; } }
    }
    __syncthreads();
}

constexpr int RG_NT = (NTOK + 63) / 64;
__device__ __forceinline__ void rg_scan_s1(const Params& p, const Ctx& c) {
    float* A = (float*)(c.ws + WS_BIG + B_A); float* X = (float*)(c.ws + WS_BIG + B_X); float* SUM = (float*)(c.ws + WS_BIG + B_U);
    for (int it = c.b; it < RG_NT * 2; it += c.G) {
        const int tile = it >> 1, ch = (it & 1) * NTHR + c.tid, t0 = tile * 64, nt = min(64, NTOK - t0);
        float hs = 0.f, pr = 1.f;
        for (int k0 = 0; k0 < nt; k0 += 16) {
            float a[16], x[16];
#pragma unroll
            for (int k = 0; k < 16; ++k) { const size_t o = (size_t)row_of(t0 + k0 + k) * 1024 + ch; a[k] = A[o]; x[k] = X[o]; }
#pragma unroll
            for (int k = 0; k < 16; ++k) { const size_t o = (size_t)row_of(t0 + k0 + k) * 1024 + ch; hs = a[k] * hs + x[k]; pr *= a[k]; X[o] = hs; A[o] = pr; }
        }
        SUM[(size_t)(tile * 2) * 1024 + ch] = pr; SUM[(size_t)(tile * 2 + 1) * 1024 + ch] = hs;
    }
}
__device__ __forceinline__ void rg_scan_s2(const Params& p, const Ctx& c) {
    float* SUM = (float*)(c.ws + WS_BIG + B_U);
    const int ch = c.b * NTHR + c.tid; if (ch >= 1024) return;
    float carry = 0.f;
    for (int t0 = 0; t0 < RG_NT; t0 += 16) {
        float pr[16], hs[16];
#pragma unroll
        for (int k = 0; k < 16; ++k) { const int tile = t0 + k; if (tile < RG_NT) { pr[k] = SUM[(size_t)(tile * 2) * 1024 + ch]; hs[k] = SUM[(size_t)(tile * 2 + 1) * 1024 + ch]; } else { pr[k] = 1.f; hs[k] = 0.f; } }
#pragma unroll
        for (int k = 0; k < 16; ++k) { const int tile = t0 + k; if (tile < RG_NT) { SUM[(size_t)(tile * 2) * 1024 + ch] = carry; carry = pr[k] * carry + hs[k]; } }
    }
}
__device__ __forceinline__ void rg_scan_s23(const Params& p, const Ctx& c) {
    const bf16_t* proj = (const bf16_t*)(c.ws + WS_BIG + B_PROJ); const float* SUM = (const float*)(c.ws + WS_C + (size_t)ROWS * 256);
    bf16_t* MO = (bf16_t*)(c.ws + WS_HN);
    for (int it = c.b * NWAVES + c.wave; it < RG_NT * 16; it += c.G * NWAVES) {
        const int tile = RG_NT - 1 - (it >> 4), ch = (it & 15) * 64 + c.lane, t0 = tile * 64, nt = min(64, NTOK - t0);
        unsigned ax[64]; unsigned short gt[64];
#pragma unroll
        for (int k = 0; k < 64; ++k) { const int row = row_of(min(t0 + k, NTOK - 1)); ax[k] = (unsigned)MO[(size_t)row * DM + 1024 + ch] | ((unsigned)MO[(size_t)row * DM + ch] << 16); gt[k] = proj[(size_t)row * N_CDP + 1024 + ch]; }
        float carry = 0.f;
        for (int tp = 0; tp < tile; tp += 16) {
            float pr[16], hs[16];
#pragma unroll
            for (int k = 0; k < 16; ++k) { const int tt = min(tp + k, tile - 1); pr[k] = SUM[(size_t)(tt * 2) * 1024 + ch]; hs[k] = SUM[(size_t)(tt * 2 + 1) * 1024 + ch]; }
#pragma unroll
            for (int k = 0; k < 16; ++k) if (tp + k < tile) carry = pr[k] * carry + hs[k];
        }
#pragma unroll
        for (int k = 0; k < 64; ++k) if (k < nt) { const int row = row_of(t0 + k); MO[(size_t)row * DM + ch] = (bf16_t)f2bf((bflo(ax[k]) + bfhi(ax[k]) * carry) * gelu_tanh(bf2f(gt[k]))); }
    }
}

__device__ __forceinline__ void phase_scores_mfma(const Params& p, const Ctx& c) {
    const bf16_t* proj = (const bf16_t*)(c.ws + WS_BIG + B_PROJ); float* SC = (float*)(c.ws + WS_BIG + B_SC);
    const int n = c.lane & 15, g = c.lane >> 4;
    for (int it = c.b; it < NREAL / 32; it += c.G) {
        const int q0 = (NREAL / 32 - 1 - it) * 32 + c.wave * 4;
        bf16x8 a[4][2]; f32x4 w[4];
#pragma unroll
        for (int qq = 0; qq < 4; ++qq) { const bf16_t* pr = proj + (size_t)(q0 + qq) * N_CDP;
            a[qq][0] = *(const bf16x8*)(pr + 3328 + n * 64 + 8 * g); a[qq][1] = *(const bf16x8*)(pr + 3328 + n * 64 + 32 + 8 * g);
            const u32x2 wv = *(const u32x2*)(pr + 4416 + 4 * g); w[qq] = (f32x4){bflo(wv.x), bfhi(wv.x), bflo(wv.y), bfhi(wv.y)} * 0.03125f; }
        const int ntile = (q0 + 3) / 16 + 1;
        size_t off[4]; int lim[4];
#pragma unroll
        for (int qq = 0; qq < 4; ++qq) { off[qq] = sc_off(q0 + qq); lim[qq] = (((q0 + qq) >> 7) + 1) * 128; }
        for (int kt = 0; kt < ntile; ++kt) {
            const bf16_t* kr = proj + (size_t)(kt * 16 + n) * N_CDP + 4352 + 8 * g;
            const bf16x8 b0 = *(const bf16x8*)kr, b1 = *(const bf16x8*)(kr + 32);
#pragma unroll
            for (int qq = 0; qq < 4; ++qq) {
                f32x4 acc = (f32x4){0.f, 0.f, 0.f, 0.f};
                acc = __builtin_amdgcn_mfma_f32_16x16x32_bf16(a[qq][0], b0, acc, 0, 0, 0); acc = __builtin_amdgcn_mfma_f32_16x16x32_bf16(a[qq][1], b1, acc, 0, 0, 0);
                float s = fmaxf(acc[0], 0.f) * w[qq][0] + fmaxf(acc[1], 0.f) * w[qq][1] + fmaxf(acc[2], 0.f) * w[qq][2] + fmaxf(acc[3], 0.f) * w[qq][3];
                s += __shfl_xor(s, 16); s += __shfl_xor(s, 32);
                const int key = kt * 16 + n; if (g == 0 && key < lim[qq]) SC[off[qq] + key] = s;
            }
        }
    }
}

__device__ __forceinline__ void phase_scores_simple(const Params& p, const Ctx& c) {
    const bf16_t* proj = (const bf16_t*)(c.ws + WS_BIG + B_PROJ); float* SC = (float*)(c.ws + WS_BIG + B_SC);
    LAS float* siq = (LAS float*)c.lds;
    LAS float* sw = siq + 16384;
    int id = 0;
    for (int qt = 0; qt < NREAL / 16; ++qt) {
        const int q0 = qt * 16, nch = (q0 + 15) / 512 + 1;
        for (int kc = 0; kc < nch; ++kc, ++id) {
            if (id % c.G != c.b) continue;
            __syncthreads();
            for (int i = c.tid; i < 16 * 128; i += NTHR) { const int qq = i >> 7, c8 = (i & 127) * 8; const u32x4 v = *(const u32x4*)(proj + (size_t)(q0 + qq) * N_CDP + 3328 + c8);
                LAS float* d = siq + qq * 1024 + c8; d[0] = bflo(v.x); d[1] = bfhi(v.x); d[2] = bflo(v.y); d[3] = bfhi(v.y); d[4] = bflo(v.z); d[5] = bfhi(v.z); d[6] = bflo(v.w); d[7] = bfhi(v.w); }
            if (c.tid < 256) sw[c.tid] = bf2f(proj[(size_t)(q0 + (c.tid >> 4)) * N_CDP + 4416 + (c.tid & 15)]);
            __syncthreads();
            const int s = kc * 512 + c.tid;
            if (s <= q0 + 15) {
                float ik[64];
#pragma unroll
                for (int j = 0; j < 8; ++j) { const u32x4 v = *(const u32x4*)(proj + (size_t)s * N_CDP + 4352 + j * 8);
                    ik[j * 8 + 0] = bflo(v.x); ik[j * 8 + 1] = bfhi(v.x); ik[j * 8 + 2] = bflo(v.y); ik[j * 8 + 3] = bfhi(v.y); ik[j * 8 + 4] = bflo(v.z); ik[j * 8 + 5] = bfhi(v.z); ik[j * 8 + 6] = bflo(v.w); ik[j * 8 + 7] = bfhi(v.w); }
                for (int qq = 0; qq < 16; ++qq) {
                    float sc = 0.f;
                    for (int h = 0; h < 16; ++h) {
                        const LAS f32x4* a = (const LAS f32x4*)(siq + qq * 1024 + h * 64); float d = 0.f;
#pragma unroll
                        for (int j = 0; j < 16; ++j) { const f32x4 av = a[j]; d += av[0] * ik[4 * j] + av[1] * ik[4 * j + 1] + av[2] * ik[4 * j + 2] + av[3] * ik[4 * j + 3]; }
                        sc += fmaxf(d, 0.f) * sw[qq * 16 + h];
                    }
                    const int q = q0 + qq; if (s < ((q >> 7) + 1) * 128) SC[sc_off(q) + s] = sc * 0.03125f;
                }
            }
        }
    }
}
__device__ __forceinline__ void phase_select(const Params& p, const Ctx& c) {
    const float* SC = (const float*)(c.ws + WS_BIG + B_SC); int* IDX = (int*)(c.ws + WS_IDX);
    LAS int* sc0 = (LAS int*)c.lds;
    LAS int* sc1 = sc0 + 16;
    const unsigned long long lt_mask = (1ull << c.lane) - 1ull;
    for (int q = c.b; q < NREAL; q += c.G) {
        int* out = IDX + (size_t)q * 256;
        if (q < 256) { if (c.tid < 256) out[c.tid] = c.tid <= q ? c.tid : -1; continue; }
        __syncthreads();
        const float* row = SC + sc_off(q);
        unsigned key[16];
#pragma unroll
        for (int j = 0; j < 16; ++j) { const int s = j * 512 + c.tid; unsigned k = 0u; if (s <= q) { const unsigned b = __float_as_uint(row[s]); k = (b & 0x80000000u) ? ~b : (b | 0x80000000u); } key[j] = k; }
        unsigned prefix = 0u;
        for (int bit = 31; bit >= 0; --bit) {
            const unsigned cand = prefix | (1u << bit); int cnt = 0;
#pragma unroll
            for (int j = 0; j < 16; ++j) cnt += __popcll(__ballot(key[j] >= cand));
            LAS int* buf = sc0 + (bit & 1) * 8;
            if (c.lane == 0) buf[c.wave] = cnt;
            __syncthreads();
            int tot = 0;
#pragma unroll
            for (int w = 0; w < 8; ++w) tot += buf[w];
            if (tot >= 256) prefix = cand;
            if (tot == 256) break;
        }
        int cg = 0, ce = 0;
#pragma unroll
        for (int j = 0; j < 16; ++j) { cg += __popcll(__ballot(key[j] > prefix)); ce += __popcll(__ballot(key[j] == prefix)); }
        if (c.lane == 0) { sc1[c.wave] = cg; sc1[8 + c.wave] = ce; }
        __syncthreads();
        int totg = 0, tote = 0;
#pragma unroll
        for (int w = 0; w < 8; ++w) { totg += sc1[w]; tote += sc1[8 + w]; }
        const int need = 256 - totg;
        unsigned takebits = 0u;
        if (need >= tote) {
#pragma unroll
            for (int j = 0; j < 16; ++j) takebits |= (key[j] >= prefix ? 1u : 0u) << j;
        } else {
            int eq_seen = 0;
            for (int j = 0; j < 16; ++j) {
                unsigned kj = 0u;
#pragma unroll
                for (int jj = 0; jj < 16; ++jj) kj = jj == j ? key[jj] : kj;
                const bool eq = kj == prefix; const unsigned long long meq = __ballot(eq);
                __syncthreads();
                if (c.lane == 0) sc0[c.wave] = __popcll(meq);
                __syncthreads();
                int base = eq_seen, all = 0;
#pragma unroll
                for (int w = 0; w < 8; ++w) { const int v = sc0[w]; base += w < c.wave ? v : 0; all += v; }
                const bool take = kj > prefix || (eq && base + __popcll(meq & lt_mask) < need);
                takebits |= (take ? 1u : 0u) << j; eq_seen += all;
            }
        }
        int tk = 0;
#pragma unroll
        for (int j = 0; j < 16; ++j) tk += __popcll(__ballot((takebits >> j) & 1u));
        if (c.lane == 0) sc1[16 + c.wave] = tk;
        __syncthreads();
        int pos = 0;
#pragma unroll
        for (int w = 0; w < 8; ++w) pos += w < c.wave ? sc1[16 + w] : 0;
#pragma unroll
        for (int j = 0; j < 16; ++j) { const bool t = (takebits >> j) & 1u; const unsigned long long mt = __ballot(t);
            if (t) out[pos + __popcll(mt & lt_mask)] = j * 512 + c.tid;
            pos += __popcll(mt); }
    }
}
__device__ __forceinline__ unsigned sel_key(float x) { const unsigned b = __float_as_uint(x); return (b & 0x80000000u) ? ~b : (b | 0x80000000u); }
__device__ __forceinline__ float relu_i(float x) { return __int_as_float(max(__float_as_int(x), 0)); }
__device__ __forceinline__ void phase_scores_v2(const Params& p, const Ctx& c) {
    const bf16_t* proj = (const bf16_t*)(c.ws + WS_BIG + B_PROJ); float* SC = (float*)(c.ws + WS_BIG + B_SC); unsigned short* GM = (unsigned short*)(c.ws + WS_GM);
    const int n = c.lane & 15, g = c.lane >> 4;
    constexpr int NITEM = 2176, KP = 72;
    LAS bf16_t* kb = (LAS bf16_t*)c.lds;
    const int lkey = c.tid >> 1, lhalf = c.tid & 1;
    for (int id = c.b; id < NITEM; id += c.G) {
        const int rid = NITEM - 1 - id;
        int a = 0; while (a < 15 && 8 * (a + 1) * (a + 2) <= rid) ++a;
        const int rem = rid - 8 * a * (a + 1), qt = 16 * a + rem / (a + 1), kc = rem % (a + 1);
        const int q0 = qt * 32 + c.wave * 4;
        bf16x8 af[4][2]; f32x4 w[4];
#pragma unroll
        for (int qq = 0; qq < 4; ++qq) { const bf16_t* pr = proj + (size_t)(q0 + qq) * N_CDP;
            af[qq][0] = *(const bf16x8*)(pr + 3328 + n * 64 + 8 * g); af[qq][1] = *(const bf16x8*)(pr + 3328 + n * 64 + 32 + 8 * g);
            const u32x2 wv = *(const u32x2*)(pr + 4416 + 4 * g); w[qq] = (f32x4){bflo(wv.x), bfhi(wv.x), bflo(wv.y), bfhi(wv.y)} * 0.03125f; }
        const int g0 = kc * 8, g1 = min(g0 + 8, (qt * 32 + 31) / 64 + 1);
        const int nss = (g1 - g0 + 3) >> 2;
        float* orow[4]; int lim[4]; float gmx[4] = {-INFINITY, -INFINITY, -INFINITY, -INFINITY};
#pragma unroll
        for (int qq = 0; qq < 4; ++qq) { orow[qq] = SC + sc_off(q0 + qq); lim[qq] = (((q0 + qq) >> 7) + 1) * 128; }
        u32x4 st[4];
        { const bf16_t* src = proj + (size_t)(g0 * 64 + lkey) * N_CDP + 4352 + lhalf * 32;
#pragma unroll
          for (int i = 0; i < 4; ++i) st[i] = *(const u32x4*)(src + 8 * i); }
        __syncthreads();
        for (int ss = 0; ss < nss; ++ss) {
            LAS bf16_t* buf = kb + (ss & 1) * 256 * KP;
#pragma unroll
            for (int i = 0; i < 4; ++i) *(LAS u32x4*)(buf + lkey * KP + lhalf * 32 + 8 * i) = st[i];
            if (ss + 1 < nss) { const bf16_t* src = proj + (size_t)((g0 + 4 * (ss + 1)) * 64 + lkey) * N_CDP + 4352 + lhalf * 32;
#pragma unroll
                for (int i = 0; i < 4; ++i) st[i] = *(const u32x4*)(src + 8 * i); }
            __syncthreads();
            const int nk = min(4, g1 - g0 - 4 * ss);
#ifndef SCDUP
#define SCDUP 1
#endif
            for (int dup_ = 0; dup_ < SCDUP; ++dup_)
            for (int kl = 0; kl < nk; ++kl) {
                const int kg = g0 + 4 * ss + kl; const int key = kg * 64 + c.lane;
                bf16x8 cb[4][2];
#pragma unroll
                for (int t = 0; t < 4; ++t) { cb[t][0] = *(const LAS bf16x8*)(buf + (kl * 64 + 16 * t + n) * KP + 8 * g); cb[t][1] = *(const LAS bf16x8*)(buf + (kl * 64 + 16 * t + n) * KP + 32 + 8 * g); }
                f32x4 acc[4][4];
#pragma unroll
                for (int qq = 0; qq < 4; ++qq)
#pragma unroll
                    for (int t = 0; t < 4; ++t) acc[qq][t] = __builtin_amdgcn_mfma_f32_16x16x32_bf16(af[qq][0], cb[t][0], (f32x4){0.f, 0.f, 0.f, 0.f}, 0, 0, 0);
#pragma unroll
                for (int qq = 0; qq < 4; ++qq)
#pragma unroll
                    for (int t = 0; t < 4; ++t) acc[qq][t] = __builtin_amdgcn_mfma_f32_16x16x32_bf16(af[qq][1], cb[t][1], acc[qq][t], 0, 0, 0);
                float sq[4][4];
#pragma unroll
                for (int qq = 0; qq < 4; ++qq)
#pragma unroll
                    for (int t = 0; t < 4; ++t) sq[qq][t] = relu_i(acc[qq][t][0]) * w[qq][0] + relu_i(acc[qq][t][1]) * w[qq][1] + relu_i(acc[qq][t][2]) * w[qq][2] + relu_i(acc[qq][t][3]) * w[qq][3];
#pragma unroll
                for (int qq = 0; qq < 4; ++qq) {
                    auto s01 = __builtin_amdgcn_permlane16_swap(__float_as_uint(sq[qq][0]), __float_as_uint(sq[qq][1]), false, false);
                    auto s23 = __builtin_amdgcn_permlane16_swap(__float_as_uint(sq[qq][2]), __float_as_uint(sq[qq][3]), false, false);
                    const float e01 = __uint_as_float(s01[0]) + __uint_as_float(s01[1]), e23 = __uint_as_float(s23[0]) + __uint_as_float(s23[1]);
                    auto su = __builtin_amdgcn_permlane32_swap(__float_as_uint(e01), __float_as_uint(e23), false, false);
                    const float sv = __uint_as_float(su[0]) + __uint_as_float(su[1]);
                    if (kg * 64 < lim[qq]) __builtin_nontemporal_store(sv, orow[qq] + (unsigned)key);
                    if (kg * 64 + 63 <= q0) gmx[qq] = fmaxf(gmx[qq], sv); else if (key <= q0 + qq) gmx[qq] = fmaxf(gmx[qq], sv);
                    if ((kg & 7) == 7 || kg + 1 == g1) { GM[((size_t)(q0 + qq) * 16 + (kg >> 3)) * 64 + c.lane] = (unsigned short)(gmx[qq] == -INFINITY ? 0u : (sel_key(gmx[qq]) >> 16)); gmx[qq] = -INFINITY; }
                }
            }
        }
    }
    __syncthreads();
}
__device__ __forceinline__ int wave_isum(int v) {
#pragma unroll
    for (int o = 1; o < 64; o <<= 1) v += __shfl_xor(v, o);
    return v;
}
template <int NS>
__device__ __forceinline__ void select_group(const Ctx& c, const float* SC, int* IDX, int q0) {
    LAS int* cnt = (LAS int*)c.lds;
    LAS int* aux = cnt + 16;
    const int rr = c.wave >> 1, hw = c.wave & 1, q = q0 + rr, l128 = hw * 64 + c.lane;
    const unsigned long long lt_mask = (1ull << c.lane) - 1ull;
    const float* row = SC + sc_off(q); int* out = IDX + (size_t)q * 256;
    unsigned key[NS];
#pragma unroll
    for (int j = 0; j < NS; ++j) { const int s = j * 128 + l128; key[j] = s <= q ? sel_key(row[s]) : 0u; }
    unsigned prefix = 0u; bool done = false;
#pragma nounroll
    for (int bit = 31; bit >= 0; --bit) {
        const unsigned cand = prefix | (1u << bit); int cn = 0;
        if (!done) {
#pragma unroll
            for (int j0 = 0; j0 < NS; j0 += 8) { int part = 0;
#pragma unroll
                for (int j = j0; j < j0 + 8; ++j) part += __popcll(__ballot(key[j] >= cand));
                cn += part; asm volatile("" : "+s"(cn)); } }
        LAS int* buf = cnt + (bit & 1) * 8;
        if (c.lane == 0) buf[c.wave] = done ? -1 : cn;
        __syncthreads();
        if (!done) { const int tot = buf[2 * rr] + buf[2 * rr + 1]; if (tot >= 256) prefix = cand; if (tot == 256) done = true; }
        bool alld = true;
#pragma unroll
        for (int w = 0; w < 8; ++w) alld = alld && (buf[w] == -1);
        if (alld) break;
    }
    int cg = 0, ce = 0;
#pragma unroll
    for (int j = 0; j < NS; ++j) { cg += key[j] > prefix ? 1 : 0; ce += key[j] == prefix ? 1 : 0; }
    cg = wave_isum(cg); ce = wave_isum(ce);
    __syncthreads();
    if (c.lane == 0) { aux[c.wave] = cg; aux[8 + c.wave] = ce; }
    __syncthreads();
    const int need = 256 - (aux[2 * rr] + aux[2 * rr + 1]);
    bool anytie = false;
#pragma unroll
    for (int r2 = 0; r2 < 4; ++r2) anytie = anytie || (256 - (aux[2 * r2] + aux[2 * r2 + 1]) < aux[8 + 2 * r2] + aux[8 + 2 * r2 + 1]);
    int T = NREAL;
    if (anytie) {
        int lo = 0, hi = NREAL - 1;
#pragma nounroll
        for (int it = 0; it < 13; ++it) {
            const int mid = (lo + hi) >> 1; int cn = 0;
#pragma unroll
            for (int j = 0; j < NS; ++j) cn += (key[j] == prefix && j * 128 + l128 <= mid) ? 1 : 0;
            cn = wave_isum(cn);
            __syncthreads();
            if (c.lane == 0) cnt[c.wave] = cn;
            __syncthreads();
            if (cnt[2 * rr] + cnt[2 * rr + 1] >= need) hi = mid; else lo = mid + 1;
        }
        T = lo;
    }
    int tk = 0;
#pragma unroll
    for (int j = 0; j < NS; ++j) tk += (key[j] > prefix || (key[j] == prefix && j * 128 + l128 <= T)) ? 1 : 0;
    tk = wave_isum(tk);
    __syncthreads();
    if (c.lane == 0) aux[16 + c.wave] = tk;
    __syncthreads();
    int pos = hw ? aux[16 + 2 * rr] : 0;
#pragma unroll
    for (int j = 0; j < NS; ++j) { const bool t = key[j] > prefix || (key[j] == prefix && j * 128 + l128 <= T); const unsigned long long mt = __ballot(t);
        if (t) out[pos + __popcll(mt & lt_mask)] = j * 128 + l128;
        pos += __popcll(mt); }
    __syncthreads();
}
constexpr int SEL_CAP = 2048;
__device__ __forceinline__ void select_row_slow(const Ctx& c, const float* row, int q, int* out) {
    const unsigned long long lt_mask = (1ull << c.lane) - 1ull; const int slots = (q + 64) >> 6; unsigned prefix = 0u;
    for (int bit = 31; bit >= 0; --bit) { const unsigned cand = prefix | (1u << bit); int cnt = 0;
        for (int j = 0; j < slots; ++j) { const int s = j * 64 + c.lane; const unsigned k = s <= q ? sel_key(row[s]) : 0u; cnt += __popcll(__ballot(k >= cand)); }
        if (cnt >= 256) prefix = cand; }
    int cgt = 0;
    for (int j = 0; j < slots; ++j) { const int s = j * 64 + c.lane; const unsigned k = s <= q ? sel_key(row[s]) : 0u; cgt += __popcll(__ballot(k > prefix)); }
    const int need = 256 - cgt; int eq_seen = 0, outc = 0;
    for (int j = 0; j < slots; ++j) { const int s = j * 64 + c.lane; const unsigned k = s <= q ? sel_key(row[s]) : 0u; const bool eq = k == prefix; const unsigned long long meq = __ballot(eq);
        const bool take = k > prefix || (eq && eq_seen + __popcll(meq & lt_mask) < need); const unsigned long long mt = __ballot(take);
        if (take) out[outc + __popcll(mt & lt_mask)] = s; outc += __popcll(mt); eq_seen += __popcll(meq); }
}
template <int NSL>
__device__ __forceinline__ void select_finish(const Ctx& c, LAS unsigned* lk, LAS unsigned short* li, int* out) {
    const unsigned long long lt_mask = (1ull << c.lane) - 1ull;
    unsigned kk[NSL];
#pragma unroll
    for (int i = 0; i < NSL; ++i) kk[i] = lk[i * 64 + c.lane];
    unsigned prefix = 0u;
#pragma nounroll
    for (int bit = 31; bit >= 0; --bit) { const unsigned cand = prefix | (1u << bit); int cnt = 0;
#pragma unroll
        for (int i = 0; i < NSL; ++i) cnt += __popcll(__ballot(kk[i] >= cand));
        if (cnt >= 256) prefix = cand;
        if (cnt == 256) break; }
    int cgt = 0, ceq = 0;
#pragma unroll
    for (int i = 0; i < NSL; ++i) { cgt += __popcll(__ballot(kk[i] > prefix)); ceq += __popcll(__ballot(kk[i] == prefix)); }
    const int need = 256 - cgt; int T = 0xffff;
    if (need < ceq) {
        int lo = 0, hi = NREAL - 1;
#pragma nounroll
        for (int it = 0; it < 13; ++it) { const int mid = (lo + hi) >> 1; int cn = 0;
#pragma unroll
            for (int i = 0; i < NSL; ++i) cn += __popcll(__ballot(kk[i] == prefix && (int)li[i * 64 + c.lane] <= mid));
            if (cn >= need) hi = mid; else lo = mid + 1; }
        T = lo;
    }
    int outc = 0;
#pragma unroll
    for (int i = 0; i < NSL; ++i) { const int s = li[i * 64 + c.lane]; const bool take = kk[i] > prefix || (kk[i] == prefix && s <= T); const unsigned long long mt = __ballot(take);
        if (take) out[outc + __popcll(mt & lt_mask)] = s;
        outc += __popcll(mt); }
}
__device__ __forceinline__ void phase_select_v3(const Params& p, const Ctx& c, const int klo, const int khi) {
    const float* SC = (const float*)(c.ws + WS_BIG + B_SC); int* IDX = (int*)(c.ws + WS_IDX);
    LAS unsigned* lk = (LAS unsigned*)(c.lds + c.wave * 17408); LAS unsigned short* li = (LAS unsigned short*)(lk + SEL_CAP);
#ifndef SELDUP2
#define SELDUP2 1
#endif
#pragma nounroll
    for (int rep_ = 0; rep_ < SELDUP2; ++rep_)
    for (int k_ = klo; k_ < khi; ++k_) { const int q = c.b * NWAVES + c.wave + k_ * c.G * NWAVES; if (q >= NREAL) break;
        int* out = IDX + (size_t)q * 256;
        if (q < 256) {
#pragma unroll
            for (int j = 0; j < 4; ++j) { const int s = j * 64 + c.lane; out[s] = s <= q ? s : -1; }
            continue; }
        const float* row = SC + sc_off(q); const int slots = (q + 64) >> 6;
        float ka[32], kb[32], kc[32];
        int ln = c.lane; asm volatile("" : "+v"(ln));
        auto loadb = [&](float (&k)[32], const int b4) __attribute__((always_inline)) {
#pragma unroll
            for (int i = 0; i < 32; ++i) { const int sb = (b4 * 32 + i) * 64, s = sb + ln;
                if (sb + 63 <= q) k[i] = __builtin_nontemporal_load(row + (unsigned)s); else k[i] = s <= q ? __builtin_nontemporal_load(row + (unsigned)s) : -INFINITY; } };
        unsigned gm[16];
        const bool big = q + 1 > SEL_CAP;
        { const unsigned short* GM = (const unsigned short*)(c.ws + WS_GM) + (size_t)q * 1024; const int ng = big ? (slots + 7) >> 3 : 0;
#pragma unroll
          for (int i = 0; i < 16; ++i) gm[i] = i < ng ? (unsigned)GM[i * 64 + ln] : 0u; }
        loadb(ka, 0);
        if (32 < slots) loadb(kb, 1);
        unsigned tau0 = 0u;
        if (big) {
#pragma nounroll
            for (int bit = 15; bit >= 0; --bit) { const unsigned cand = tau0 | (1u << bit); int cnt = 0;
#pragma unroll
                for (int i = 0; i < 16; ++i) cnt += __popcll(__ballot(gm[i] >= cand));
                if (cnt >= 256) tau0 = cand; }
            tau0 <<= 16;
        }
#pragma unroll
        for (int i = 0; i < 32; ++i) lk[i * 64 + c.lane] = 0u;
        int cntl = 0;
        const float tauf = tau0 == 0u ? -INFINITY : __uint_as_float((tau0 & 0x80000000u) ? (tau0 & 0x7fffffffu) : ~tau0);
        auto procb = [&](const float (&k)[32], const int b4) __attribute__((always_inline)) {
#pragma unroll
            for (int i = 0; i < 32; ++i) { const int s = (b4 * 32 + i) * 64 + ln; const bool sv = tau0 == 0u ? s <= q : k[i] >= tauf;
                if (sv && cntl < 32) { lk[cntl * 64 + ln] = sel_key(k[i]); li[cntl * 64 + ln] = (unsigned short)s; }
                cntl += sv ? 1 : 0; } };
        if (64 < slots) loadb(kc, 2);
        procb(ka, 0);
        if (96 < slots) loadb(ka, 3);
        if (32 < slots) procb(kb, 1);
        if (64 < slots) procb(kc, 2);
        if (96 < slots) procb(ka, 3);
        LDS_WAIT();
        int mx = cntl;
#pragma unroll
        for (int o = 1; o < 64; o <<= 1) mx = max(mx, __shfl_xor(mx, o));
        mx = __builtin_amdgcn_readfirstlane(mx);
        if (mx > 32) select_row_slow(c, row, q, out);
        else if (mx <= 8) select_finish<8>(c, lk, li, out);
        else if (mx <= 16) select_finish<16>(c, lk, li, out);
        else select_finish<32>(c, lk, li, out);
        LDS_WAIT();
    }
    asm volatile("s_waitcnt vmcnt(0)" ::: "memory");
}
__device__ __forceinline__ void phase_select_v2(const Params& p, const Ctx& c) {
    const float* SC = (const float*)(c.ws + WS_BIG + B_SC); int* IDX = (int*)(c.ws + WS_IDX);
    for (int gi = c.b; gi < NREAL / 4; gi += c.G) {
        const int q0 = gi * 4;
        if (q0 < 256) { const int q = q0 + (c.wave >> 1), s0 = (c.wave & 1) * 128; int* out = IDX + (size_t)q * 256;
            out[s0 + c.lane] = (s0 + c.lane) <= q ? s0 + c.lane : -1; out[s0 + 64 + c.lane] = (s0 + 64 + c.lane) <= q ? s0 + 64 + c.lane : -1; continue; }
        if (q0 + 3 < 2048) select_group<16>(c, SC, IDX, q0);
        else if (q0 + 3 < 4096) select_group<32>(c, SC, IDX, q0);
        else select_group<64>(c, SC, IDX, q0);
    }
}
__device__ __forceinline__ void phase_qlat(const Params& p, const Ctx& c) {
    const bf16_t* proj = (const bf16_t*)(c.ws + WS_BIG + B_PROJ); bf16_t* QL = (bf16_t*)(c.ws + WS_QL); const float* wuk = p.in[I_WUK];
    LAS float* sq = (LAS float*)c.lds;
    const int sub = c.tid >> 8, r = c.tid & 255; constexpr int NT32 = (NTOK + 31) / 32;
    for (int it = c.b; it < NT32 * 8; it += c.G) {
        const int tile = it >> 3, h = it & 7, r0 = tile * 32;
        __syncthreads();
        for (int i = c.tid; i < 32 * 16; i += NTHR) { const int rr = i >> 4, c8 = (i & 15) * 8; const int row = r0 + rr;
            u32x4 v = (u32x4){0u, 0u, 0u, 0u}; if (row < NTOK) v = *(const u32x4*)(proj + (size_t)row * N_CDP + 2048 + h * 128 + c8);
            LAS float* d = sq + rr * 128 + c8; d[0] = bflo(v.x); d[1] = bfhi(v.x); d[2] = bflo(v.y); d[3] = bfhi(v.y); d[4] = bflo(v.z); d[5] = bfhi(v.z); d[6] = bflo(v.w); d[7] = bfhi(v.w); }
        __syncthreads();
        float acc[16];
#pragma unroll
        for (int k = 0; k < 16; ++k) acc[k] = 0.f;
        const float* w = wuk + (size_t)r * 1024 + h * 128;
        for (int d = 0; d < 128; d += 4) { const f32x4 wv = *(const f32x4*)(w + d);
#pragma unroll
            for (int k = 0; k < 16; ++k) { const f32x4 qv = *(const LAS f32x4*)(sq + (sub * 16 + k) * 128 + d); acc[k] += qv[0] * wv[0] + qv[1] * wv[1] + qv[2] * wv[2] + qv[3] * wv[3]; } }
#pragma unroll
        for (int k = 0; k < 16; ++k) { const int row = r0 + sub * 16 + k; if (row < NTOK) QL[(size_t)row * DM + h * 256 + r] = (bf16_t)f2bf(acc[k] * 0.08838834764831845f); }
    }
}
__device__ __forceinline__ void phase_attn_simple(const Params& p, const Ctx& c) {
    const bf16_t* QL = (const bf16_t*)(c.ws + WS_QL); bf16_t* OL = (bf16_t*)(c.ws + WS_BIG + B_OL); const bf16_t* C = (const bf16_t*)(c.ws + WS_C); const int* IDX = (const int*)(c.ws + WS_IDX);
    LAS float* sq = (LAS float*)c.lds + c.wave * 256;
    for (int it = c.b * NWAVES + c.wave; it < NTOK * 8; it += c.G * NWAVES) {
        const int row = it >> 3, h = it & 7;
        { const u32x2 v = *(const u32x2*)(QL + (size_t)row * DM + h * 256 + 4 * c.lane); *(LAS f32x4*)(sq + 4 * c.lane) = (f32x4){bflo(v.x), bfhi(v.x), bflo(v.y), bfhi(v.y)}; }
        LDS_WAIT();
        float s[5]; int kr[5];
#pragma unroll
        for (int r5 = 0; r5 < 5; ++r5) {
            const int j = r5 * 64 + c.lane; bool valid = false; int k = 0;
            if (row >= NREAL) { valid = j <= row - NREAL; k = NREAL + j; }
            else if (j < 16) { valid = true; k = NREAL + j; }
            else if (j < 272) { k = IDX[(size_t)row * 256 + j - 16]; valid = k >= 0; }
            float d = 0.f;
            if (valid) { const u32x4* cr = (const u32x4*)(C + (size_t)k * 256);
#pragma unroll 4
                for (int d8 = 0; d8 < 32; ++d8) { const u32x4 cv = cr[d8]; const f32x4 q0 = *(const LAS f32x4*)(sq + d8 * 8), q1 = *(const LAS f32x4*)(sq + d8 * 8 + 4);
                    d += q0[0] * bflo(cv.x) + q0[1] * bfhi(cv.x) + q0[2] * bflo(cv.y) + q0[3] * bfhi(cv.y) + q1[0] * bflo(cv.z) + q1[1] * bfhi(cv.z) + q1[2] * bflo(cv.w) + q1[3] * bfhi(cv.w); } }
            s[r5] = valid ? d : -INFINITY; kr[r5] = valid ? k : 0;
        }
        float m = fmaxf(fmaxf(fmaxf(s[0], s[1]), fmaxf(s[2], s[3])), s[4]); m = wave_max(m);
        float e[5], sum = 0.f;
#pragma unroll
        for (int r5 = 0; r5 < 5; ++r5) { e[r5] = s[r5] == -INFINITY ? 0.f : __expf(s[r5] - m); sum += e[r5]; }
        const float inv = 1.0f / wave_sum(sum);
        float o0 = 0.f, o1 = 0.f, o2 = 0.f, o3 = 0.f;
#pragma unroll
        for (int r5 = 0; r5 < 5; ++r5) {
            const float pr = e[r5] * inv; const int nl = r5 == 4 ? 16 : 64;
            for (int l = 0; l < nl; ++l) {
                const float pj = __int_as_float(__builtin_amdgcn_readlane(__float_as_int(pr), l));
                if (pj != 0.f) { const int k = __builtin_amdgcn_readlane(kr[r5], l); const u32x2 cv = *(const u32x2*)(C + (size_t)k * 256 + 4 * c.lane);
                    o0 += pj * bflo(cv.x); o1 += pj * bfhi(cv.x); o2 += pj * bflo(cv.y); o3 += pj * bfhi(cv.y); }
            }
        }
        *(u32x2*)(OL + (size_t)row * DM + h * 256 + 4 * c.lane) = (u32x2){pk2(o0, o1), pk2(o2, o3)};
        LDS_WAIT();
    }
}
__device__ __forceinline__ void phase_attn_fast(const Params& p, const Ctx& c) {
    const bf16_t* QL = (const bf16_t*)(c.ws + WS_QL); bf16_t* OL = (bf16_t*)(c.ws + WS_BIG + B_OL); const bf16_t* C = (const bf16_t*)(c.ws + WS_C); const int* IDX = (const int*)(c.ws + WS_IDX);
    LAS float* sp = (LAS float*)c.lds + c.wave * (272 * 8 + 272);
    LAS int* sk = (LAS int*)(sp + 272 * 8);
    const int n = c.lane & 15, g = c.lane >> 4;
    for (int row = c.b * NWAVES + c.wave; row < NTOK; row += c.G * NWAVES) {
        const bool meta = row >= NREAL; const int nt = meta ? 1 : 17;
        bf16x8 a[8];
#pragma unroll
        for (int s = 0; s < 8; ++s) { a[s] = (bf16x8){0, 0, 0, 0, 0, 0, 0, 0}; if (n < 8) a[s] = *(const bf16x8*)(QL + (size_t)row * DM + n * 256 + 32 * s + 8 * g); }
        f32x4 sc[17]; float mx[4] = {-INFINITY, -INFINITY, -INFINITY, -INFINITY};
#pragma unroll
        for (int t = 0; t < 17; ++t) {
            sc[t] = (f32x4){-INFINITY, -INFINITY, -INFINITY, -INFINITY};
            if (t < nt) {
                int k; bool valid;
                if (t == 0) { k = NREAL + n; valid = meta ? (n <= row - NREAL) : true; }
                else { k = IDX[(size_t)row * 256 + 16 * (t - 1) + n]; valid = k >= 0; k = valid ? k : 0; }
                if (g == 0) sk[16 * t + n] = k;
                f32x4 acc = (f32x4){0.f, 0.f, 0.f, 0.f}; const bf16_t* cr = C + (size_t)k * 256 + 8 * g;
#pragma unroll
                for (int s = 0; s < 8; ++s) { const bf16x8 b = *(const bf16x8*)(cr + 32 * s); acc = __builtin_amdgcn_mfma_f32_16x16x32_bf16(a[s], b, acc, 0, 0, 0); }
                if (valid) sc[t] = acc;
#pragma unroll
                for (int r = 0; r < 4; ++r) mx[r] = fmaxf(mx[r], sc[t][r]);
            }
        }
#pragma unroll
        for (int r = 0; r < 4; ++r) mx[r] = row16_max(mx[r]);
        float sm[4] = {0.f, 0.f, 0.f, 0.f};
#pragma unroll
        for (int t = 0; t < 17; ++t) if (t < nt) {
#pragma unroll
            for (int r = 0; r < 4; ++r) { const float e = sc[t][r] == -INFINITY ? 0.f : __expf(sc[t][r] - mx[r]); sc[t][r] = e; sm[r] += e; } }
#pragma unroll
        for (int r = 0; r < 4; ++r) sm[r] = 1.0f / row16_sum(sm[r]);
#pragma unroll
        for (int t = 0; t < 17; ++t) if (t < nt && g < 2) *(LAS f32x4*)(sp + (16 * t + n) * 8 + 4 * g) = (f32x4){sc[t][0] * sm[0], sc[t][1] * sm[1], sc[t][2] * sm[2], sc[t][3] * sm[3]};
        LDS_WAIT();
        f32x4 o[8];
#pragma unroll
        for (int h = 0; h < 8; ++h) o[h] = (f32x4){0.f, 0.f, 0.f, 0.f};
        for (int t = 0; t < nt; ++t) {
            u32x2 cv[16];
#pragma unroll
            for (int nn = 0; nn < 16; ++nn) { const int k = __builtin_amdgcn_readfirstlane(sk[16 * t + nn]); cv[nn] = *(const u32x2*)(C + (size_t)k * 256 + 4 * c.lane); }
#pragma unroll
            for (int nn = 0; nn < 16; ++nn) { const f32x4 p0 = *(const LAS f32x4*)(sp + (16 * t + nn) * 8), p1 = *(const LAS f32x4*)(sp + (16 * t + nn) * 8 + 4);
                const f32x4 cf = (f32x4){bflo(cv[nn].x), bfhi(cv[nn].x), bflo(cv[nn].y), bfhi(cv[nn].y)};
                o[0] += p0[0] * cf; o[1] += p0[1] * cf; o[2] += p0[2] * cf; o[3] += p0[3] * cf; o[4] += p1[0] * cf; o[5] += p1[1] * cf; o[6] += p1[2] * cf; o[7] += p1[3] * cf; }
        }
#pragma unroll
        for (int h = 0; h < 8; ++h) *(u32x2*)(OL + (size_t)row * DM + h * 256 + 4 * c.lane) = (u32x2){pk2(o[h][0], o[h][1]), pk2(o[h][2], o[h][3])};
        LDS_WAIT();
    }
}
__device__ __forceinline__ unsigned att_off_b(unsigned row, unsigned ch) { return 256u * row + 16u * (ch ^ (((row & 3u) << 2) | ((row >> 2) & 3u))); }
__device__ __forceinline__ u32x2 tr_issue(unsigned addr) { u32x2 r; asm volatile("ds_read_b64_tr_b16 %0, %1" : "=v"(r) : "v"(addr) : "memory"); return r; }
template <int OFF> __device__ __forceinline__ u32x2 tr_issue_o(unsigned addr) { u32x2 r; asm volatile("ds_read_b64_tr_b16 %0, %1 offset:%2" : "=v"(r) : "v"(addr), "n"(OFF) : "memory"); return r; }
__device__ __forceinline__ u32x2 tr_issue_h1(unsigned addr) { u32x2 r; asm volatile("ds_read_b64_tr_b16 %0, %1 offset:4096" : "=v"(r) : "v"(addr) : "memory"); return r; }
__device__ __forceinline__ void phase_attn_flash(const Params& p, const Ctx& c, const int klo, const int khi) {
    const bf16_t* QL = (const bf16_t*)(c.ws + WS_QL); bf16_t* OL = (bf16_t*)(c.ws + WS_QL);
    const unsigned char* C8 = (const unsigned char*)(c.ws + WS_C);
    const int* IDX = (const int*)(c.ws + WS_IDX);
    constexpr int WB = 2 * 8192 + 1024;
    LAS unsigned char* img = c.lds + c.wave * WB; LAS int* ix = (LAS int*)(img + 2 * 8192);
    const unsigned img_a = (unsigned)(size_t)img;
    const int n = c.lane & 15, g = c.lane >> 4, q4 = n >> 2, p4 = n & 3;
    unsigned wr_a[8];
#pragma unroll
    for (int s = 0; s < 8; ++s) wr_a[s] = (g >> 1) * 4096 + att_off_b(n, 8 * (g & 1) + s);
    const unsigned rw = 4 * g + q4, rd_z = ((rw & 3u) << 2) | ((rw >> 2) & 3u), rd_b = img_a + 256u * rw + 8 * (p4 & 1);
    unsigned rd_j[8];
#pragma unroll
    for (int j = 0; j < 8; ++j) rd_j[j] = rd_b + 16u * ((unsigned)(2 * j + (p4 >> 1)) ^ rd_z);
#ifndef ATTNDUP
#define ATTNDUP 1
#endif
#pragma nounroll
    for (int rep_ = 0; rep_ < ATTNDUP; ++rep_) {
    int idxr[4];
    { const int r0_ = min(c.b * NWAVES + c.wave + klo * c.G * NWAVES, NREAL - 1);
#pragma unroll
      for (int j = 0; j < 4; ++j) idxr[j] = __hip_atomic_load(IDX + (size_t)r0_ * 256 + 64 * j + c.lane, __ATOMIC_RELAXED, __HIP_MEMORY_SCOPE_AGENT); }
    for (int k_ = klo; k_ < khi; ++k_) { const int row = c.b * NWAVES + c.wave + k_ * c.G * NWAVES; if (row >= NTOK) break;
        const bool meta = row >= NREAL;
        if (!meta) {
#pragma unroll
            for (int j = 0; j < 4; ++j) ix[64 * j + c.lane] = idxr[j]; }
        { const int rn_ = min(row + c.G * NWAVES, NREAL - 1);
#pragma unroll
          for (int j = 0; j < 4; ++j) idxr[j] = __hip_atomic_load(IDX + (size_t)rn_ * 256 + 64 * j + c.lane, __ATOMIC_RELAXED, __HIP_MEMORY_SCOPE_AGENT); }
        bf16x8 a[8];
#pragma unroll
        for (int s = 0; s < 8; ++s) { a[s] = (bf16x8){0, 0, 0, 0, 0, 0, 0, 0}; if (n < 8) a[s] = *(const bf16x8*)(QL + (size_t)row * DM + n * 256 + 64 * g + 8 * s); }
        LDS_WAIT();
        f32x4 O[16];
#pragma unroll
        for (int cc = 0; cc < 16; ++cc) O[cc] = (f32x4){0.f, 0.f, 0.f, 0.f};
        float mrun = -INFINITY, lrun = 0.f;
        auto fetch = [&](u32x4 (&dst)[4], bool& vd, const int tile) __attribute__((always_inline)) {
            int kn = ix[16 * (tile - 1) + n]; vd = kn >= 0; kn = vd ? kn : 0; const unsigned char* cr = C8 + (size_t)kn * 256 + 64 * g;
#pragma unroll
            for (int i = 0; i < 4; ++i) dst[i] = *(const u32x4*)(cr + 16 * i); };
        auto qk = [&](const u32x4 (&raw)[4], const unsigned io) __attribute__((always_inline)) -> f32x4 {
            bf16x8 b[8];
#pragma unroll
            for (int s = 0; s < 8; ++s) { const unsigned w0 = raw[s >> 1][2 * (s & 1)], w1 = raw[s >> 1][2 * (s & 1) + 1];
                b[s] = __builtin_bit_cast(bf16x8, (u32x4){__builtin_bit_cast(unsigned, __builtin_amdgcn_cvt_scalef32_pk_bf16_fp8(w0, 1.0f, false)), __builtin_bit_cast(unsigned, __builtin_amdgcn_cvt_scalef32_pk_bf16_fp8(w0, 1.0f, true)),
                                                            __builtin_bit_cast(unsigned, __builtin_amdgcn_cvt_scalef32_pk_bf16_fp8(w1, 1.0f, false)), __builtin_bit_cast(unsigned, __builtin_amdgcn_cvt_scalef32_pk_bf16_fp8(w1, 1.0f, true))}); }
            f32x4 sc = (f32x4){0.f, 0.f, 0.f, 0.f};
#pragma unroll
            for (int s = 0; s < 8; ++s) sc = __builtin_amdgcn_mfma_f32_16x16x32_bf16(b[s], a[s], sc, 0, 0, 0);
#pragma unroll
            for (int s = 0; s < 8; ++s) *(LAS bf16x8*)(img + io + wr_a[s]) = b[s];
            return sc; };
        auto mask4 = [&](f32x4& x, const bool valid) __attribute__((always_inline)) {
            const unsigned vm = (unsigned)__ballot(valid) & 0xffffu;
            if (vm != 0xffffu) { const unsigned mb = vm >> (4 * g); x[0] = (mb & 1u) ? x[0] : -INFINITY; x[1] = (mb & 2u) ? x[1] : -INFINITY; x[2] = (mb & 4u) ? x[2] : -INFINITY; x[3] = (mb & 8u) ? x[3] : -INFINITY; } };
        u32x4 rA[4], rAn[4], rBn[4]; bool vA = meta ? (n <= row - NREAL) : true, vB = false, vAn = false, vBn = false;
        { const unsigned char* cr = C8 + (size_t)(NREAL + n) * 256 + 64 * g;
#pragma unroll
          for (int i = 0; i < 4; ++i) rA[i] = *(const u32x4*)(cr + 16 * i); }
        if (!meta) { fetch(rAn, vAn, 1); fetch(rBn, vBn, 2); }
        { f32x4 x = qk(rA, 0u);
          u32x2 v[8];
#pragma unroll
          for (int j = 0; j < 8; ++j) v[j] = tr_issue_o<0>(rd_j[j]);
          mask4(x, vA);
          const float mn = xrow16_max(fmaxf(fmaxf(x[0], x[1]), fmaxf(x[2], x[3])));
          const float e0 = __expf(x[0] - mn), e1 = __expf(x[1] - mn), e2 = __expf(x[2] - mn), e3 = __expf(x[3] - mn);
          lrun = xrow16_sum((e0 + e1) + (e2 + e3)); mrun = mn;
          const bf16x8 pb = __builtin_bit_cast(bf16x8, (u32x4){pk2(e0, e1), pk2(e2, e3), 0u, 0u});
          asm volatile("s_waitcnt lgkmcnt(0)" : "+v"(v[0]), "+v"(v[1]), "+v"(v[2]), "+v"(v[3]), "+v"(v[4]), "+v"(v[5]), "+v"(v[6]), "+v"(v[7]) :: "memory");
#pragma unroll
          for (int j = 0; j < 8; ++j) { const u32x4 au = (u32x4){v[j].x, v[j].y, v[j].x, v[j].y};
              O[j] = __builtin_amdgcn_mfma_f32_16x16x32_bf16(__builtin_bit_cast(bf16x8, au), pb, O[j], 0, 0, 0); }
#pragma unroll
          for (int j = 0; j < 8; ++j) v[j] = tr_issue_o<4096>(rd_j[j]);
          asm volatile("s_waitcnt lgkmcnt(0)" : "+v"(v[0]), "+v"(v[1]), "+v"(v[2]), "+v"(v[3]), "+v"(v[4]), "+v"(v[5]), "+v"(v[6]), "+v"(v[7]) :: "memory");
#pragma unroll
          for (int j = 0; j < 8; ++j) { const u32x4 au = (u32x4){v[j].x, v[j].y, v[j].x, v[j].y};
              O[8 + j] = __builtin_amdgcn_mfma_f32_16x16x32_bf16(__builtin_bit_cast(bf16x8, au), pb, O[8 + j], 0, 0, 0); } }
        if (!meta) {
#pragma nounroll
            for (int pr = 0; pr < 8; ++pr) {
                vA = vAn; vB = vBn;
                f32x4 xa = qk(rAn, 0u), xb = qk(rBn, 8192u);
                { const int pn = min(pr + 1, 7); fetch(rAn, vAn, 2 * pn + 1); fetch(rBn, vBn, 2 * pn + 2); }
                u32x2 va[8], vb[8];
#pragma unroll
                for (int j = 0; j < 8; ++j) { va[j] = tr_issue_o<0>(rd_j[j]); vb[j] = tr_issue_o<8192>(rd_j[j]); }
                mask4(xa, vA); mask4(xb, vB);
                const float mn = fmaxf(mrun, xrow16_max(fmaxf(fmaxf(fmaxf(xa[0], xa[1]), fmaxf(xa[2], xa[3])), fmaxf(fmaxf(xb[0], xb[1]), fmaxf(xb[2], xb[3])))));
                const float alpha = __expf(mrun - mn);
                const float e0 = __expf(xa[0] - mn), e1 = __expf(xa[1] - mn), e2 = __expf(xa[2] - mn), e3 = __expf(xa[3] - mn);
                const float e4 = __expf(xb[0] - mn), e5 = __expf(xb[1] - mn), e6 = __expf(xb[2] - mn), e7 = __expf(xb[3] - mn);
                lrun = lrun * alpha + xrow16_sum(((e0 + e1) + (e2 + e3)) + ((e4 + e5) + (e6 + e7))); mrun = mn;
                const bf16x8 pb = __builtin_bit_cast(bf16x8, (u32x4){pk2(e0, e1), pk2(e2, e3), pk2(e4, e5), pk2(e6, e7)});
                if (__ballot(alpha != 1.0f) != 0ull) {
#pragma unroll
                    for (int cc = 0; cc < 16; ++cc) O[cc] = O[cc] * alpha; }
                asm volatile("s_waitcnt lgkmcnt(0)" : "+v"(va[0]), "+v"(va[1]), "+v"(va[2]), "+v"(va[3]), "+v"(va[4]), "+v"(va[5]), "+v"(va[6]), "+v"(va[7]),
                             "+v"(vb[0]), "+v"(vb[1]), "+v"(vb[2]), "+v"(vb[3]), "+v"(vb[4]), "+v"(vb[5]), "+v"(vb[6]), "+v"(vb[7]) :: "memory");
#pragma unroll
                for (int j = 0; j < 8; ++j) { const u32x4 au = (u32x4){va[j].x, va[j].y, vb[j].x, vb[j].y};
                    O[j] = __builtin_amdgcn_mfma_f32_16x16x32_bf16(__builtin_bit_cast(bf16x8, au), pb, O[j], 0, 0, 0); }
#pragma unroll
                for (int j = 0; j < 8; ++j) { va[j] = tr_issue_o<4096>(rd_j[j]); vb[j] = tr_issue_o<12288>(rd_j[j]); }
                asm volatile("s_waitcnt lgkmcnt(0)" : "+v"(va[0]), "+v"(va[1]), "+v"(va[2]), "+v"(va[3]), "+v"(va[4]), "+v"(va[5]), "+v"(va[6]), "+v"(va[7]),
                             "+v"(vb[0]), "+v"(vb[1]), "+v"(vb[2]), "+v"(vb[3]), "+v"(vb[4]), "+v"(vb[5]), "+v"(vb[6]), "+v"(vb[7]) :: "memory");
#pragma unroll
                for (int j = 0; j < 8; ++j) { const u32x4 au = (u32x4){va[j].x, va[j].y, vb[j].x, vb[j].y};
                    O[8 + j] = __builtin_amdgcn_mfma_f32_16x16x32_bf16(__builtin_bit_cast(bf16x8, au), pb, O[8 + j], 0, 0, 0); }
            }
        }
        if (n < 8) { const float inv = 1.0f / lrun;
#pragma unroll
            for (int cc = 0; cc < 16; ++cc) *(LAS u32x2*)(img + (n * 256 + 16 * cc + 4 * g) * 2) = (u32x2){pk2(O[cc][0] * inv, O[cc][1] * inv), pk2(O[cc][2] * inv, O[cc][3] * inv)}; }
        LDS_WAIT();
#pragma unroll
        for (int i = 0; i < 4; ++i) { const u32x4 v = *(const LAS u32x4*)(img + (i * 64 + c.lane) * 16); *(u32x4*)(OL + (size_t)row * DM + (i * 64 + c.lane) * 8) = v; }
        LDS_WAIT();
    }
    }
}
__device__ __forceinline__ void phase_attproj(const Params& p, const Ctx& c) {
    const bf16_t* OL = (const bf16_t*)(c.ws + WS_BIG + B_OL); bf16_t* MO = (bf16_t*)(c.ws + WS_HN); const float* wuv = p.in[I_WUV];
    LAS float* so = (LAS float*)c.lds;
    const int sub = c.tid >> 7, d = c.tid & 127; constexpr int NT32 = (NTOK + 31) / 32;
    for (int it = c.b; it < NT32 * 8; it += c.G) {
        const int tile = it >> 3, h = it & 7, r0 = tile * 32;
        __syncthreads();
        for (int i = c.tid; i < 32 * 32; i += NTHR) { const int rr = i >> 5, c8 = (i & 31) * 8; const int row = r0 + rr;
            u32x4 v = (u32x4){0u, 0u, 0u, 0u}; if (row < NTOK) v = *(const u32x4*)(OL + (size_t)row * DM + h * 256 + c8);
            LAS float* dd = so + rr * 256 + c8; dd[0] = bflo(v.x); dd[1] = bfhi(v.x); dd[2] = bflo(v.y); dd[3] = bfhi(v.y); dd[4] = bflo(v.z); dd[5] = bfhi(v.z); dd[6] = bflo(v.w); dd[7] = bfhi(v.w); }
        __syncthreads();
        float acc[8];
#pragma unroll
        for (int k = 0; k < 8; ++k) acc[k] = 0.f;
        const float* w = wuv + h * 128 + d;
        for (int r = 0; r < 256; r += 4) { float wv[4];
#pragma unroll
            for (int j = 0; j < 4; ++j) wv[j] = w[(size_t)(r + j) * 1024];
#pragma unroll
            for (int k = 0; k < 8; ++k) { const f32x4 ov = *(const LAS f32x4*)(so + (sub * 8 + k) * 256 + r); acc[k] += ov[0] * wv[0] + ov[1] * wv[1] + ov[2] * wv[2] + ov[3] * wv[3]; } }
#pragma unroll
        for (int k = 0; k < 8; ++k) { const int row = r0 + sub * 8 + k; if (row < NTOK) MO[(size_t)row * DM + 1024 + h * 128 + d] = (bf16_t)f2bf(acc[k]); }
    }
}

#ifdef CHECKS
__device__ __forceinline__ void chk_gemm(const Ctx& c, const bf16_t* A, int lda, int K, const float* W, int ldw, int ncols, const void* out, int ldo, bool out_bf16, unsigned bit) {
    const int gid = c.b * NTHR + c.tid; if (gid >= 4096) return;
    const unsigned h = (unsigned)gid * 2654435761u; const int row = (int)((h >> 8) % NTOK); const int n = (int)(((h * 40503u) >> 4) % (unsigned)ncols);
    float acc = 0.f; for (int k = 0; k < K; ++k) acc += bf2f(A[(size_t)row * lda + k]) * W[(size_t)k * ldw + n];
    const float got = out_bf16 ? bf2f(((const bf16_t*)out)[(size_t)row * ldo + n]) : ((const float*)out)[(size_t)row * ldo + n];
    if (!(fabsf(got - acc) <= 0.03f * fabsf(acc) + 0.05f)) atomicOr((unsigned*)(c.ws + WS_CTL), bit);
}
__device__ __forceinline__ void chk_swiglu(const Ctx& c, const bf16_t* A, const float* W1, const float* W3, const bf16_t* act, unsigned bit) {
    const int gid = c.b * NTHR + c.tid; if (gid >= 4096) return;
    const unsigned h = (unsigned)gid * 2654435761u; const int row = (int)((h >> 8) % NTOK); const int n = (int)(((h * 40503u) >> 4) % (unsigned)DFF);
    float a = 0.f, b = 0.f; for (int k = 0; k < DM; ++k) { const float x = bf2f(A[(size_t)row * DM + k]); a += x * W1[(size_t)k * DFF + n]; b += x * W3[(size_t)k * DFF + n]; }
    const float ref = siluf_(a) * b, got = bf2f(act[(size_t)row * DFF + n]);
    if (!(fabsf(got - ref) <= 0.03f * fabsf(ref) + 0.05f)) atomicOr((unsigned*)(c.ws + WS_CTL), bit);
}
#ifndef RG_TMAX
#define RG_TMAX 300
#endif
__device__ __forceinline__ void chk_rg(const Params& p, const Ctx& c, unsigned bit) {
    const int gid = c.b * NTHR + c.tid; if (gid >= (RG_TMAX > 300 ? 1024 : 4096)) return;
    const bf16_t* proj = (const bf16_t*)(c.ws + WS_BIG + B_PROJ); const bf16_t* MO = (const bf16_t*)(c.ws + WS_HN);
    const unsigned h = (unsigned)gid * 2654435761u; const int t = (int)((h >> 8) % (unsigned)RG_TMAX); const int ch = (int)(((h * 40503u) >> 4) % 1024u); const int n = ch >> 7, d = ch & 127;
    const float* wa = p.in[I_RG_WA] + (size_t)n * 16384 + d; const float* wi = p.in[I_RG_WI] + (size_t)n * 16384 + d;
    const float sp = logf(1.0f + expf(-p.in[I_RG_LAM][ch]));
    float hs = 0.f;
    for (int s = 0; s <= t; ++s) {
        float ga = p.in[I_RG_BA][ch], gi = p.in[I_RG_BI][ch], ud = 0.f;
        for (int cc = 0; cc < 128; ++cc) { const int chn = n * 128 + cc; float u = p.in[I_RG_CB][chn];
            for (int j = 0; j < 4; ++j) { const int tp = s - 3 + j; if (tp >= 0) u += p.in[I_RG_CW][j * 1024 + chn] * bf2f(proj[(size_t)row_of(tp) * N_CDP + chn]); }
            ga += u * wa[cc * 128]; gi += u * wi[cc * 128]; if (cc == d) ud = u; }
        const float r = 1.0f / (1.0f + expf(-ga)), ig = 1.0f / (1.0f + expf(-gi)), la = -8.0f * r * sp, a = expf(la);
        hs = a * hs + sqrtf(1.0f - expf(2.0f * la)) * ig * ud;
    }
    const float ref = hs * gelu_tanh(bf2f(proj[(size_t)row_of(t) * N_CDP + 1024 + ch])), got = bf2f(MO[(size_t)row_of(t) * DM + ch]);
    if (!(fabsf(got - ref) <= 0.03f * fabsf(ref) + 0.01f)) atomicOr((unsigned*)(c.ws + WS_CTL), bit);
}
__device__ __forceinline__ void chk_fire(const Ctx& c, unsigned bit) { atomicOr((unsigned*)(c.ws + WS_CTL), bit); }
__device__ __forceinline__ void chk_scores(const Params& p, const Ctx& c, unsigned bit) {
    const int gid = c.b * NTHR + c.tid; if (gid >= 8192) return;
    const bf16_t* proj = (const bf16_t*)(c.ws + WS_BIG + B_PROJ); const float* SC = (const float*)(c.ws + WS_BIG + B_SC);
    const unsigned h = (unsigned)gid * 2654435761u; const int q = (int)((h >> 8) % NREAL); const int s = (int)(((h * 40503u) >> 4) % (unsigned)(q + 1));
    float sc = 0.f;
    for (int hh = 0; hh < 16; ++hh) { float d = 0.f; for (int k = 0; k < 64; ++k) d += bf2f(proj[(size_t)q * N_CDP + 3328 + hh * 64 + k]) * bf2f(proj[(size_t)s * N_CDP + 4352 + k]);
        sc += fmaxf(d * 0.125f, 0.f) * bf2f(proj[(size_t)q * N_CDP + 4416 + hh]) * 0.25f; }
    const float got = SC[sc_off(q) + s];
    if (!(fabsf(got - sc) <= 1e-3f * fabsf(sc) + 1e-3f)) chk_fire(c, bit);
}
__device__ __forceinline__ void chk_select(const Params& p, const Ctx& c, unsigned bit) {
    const int gid = c.b * NTHR + c.tid; if (gid >= 2048) return;
    const float* SC = (const float*)(c.ws + WS_BIG + B_SC); const int* IDX = (const int*)(c.ws + WS_IDX);
    const unsigned h = (unsigned)gid * 2654435761u; const int q = (int)((h >> 8) % NREAL); const float* row = SC + sc_off(q); const int* id = IDX + (size_t)q * 256;
    bool bad = false;
    if (q < 256) { int nv = 0; for (int j = 0; j < 256; ++j) { const int e = id[j]; if (e >= 0) { ++nv; if (e > q) bad = true; } } if (nv != q + 1) bad = true;
        for (int j = 0; j < 256; ++j) for (int k = j + 1; k < 256; ++k) if (id[j] >= 0 && id[j] == id[k]) bad = true; }
    else { float m = INFINITY; for (int j = 0; j < 256; ++j) { const int e = id[j]; if (e < 0 || e > q) { bad = true; break; } m = fminf(m, row[e]); }
        if (!bad) { int gt = 0, ge = 0; for (int s = 0; s <= q; ++s) { gt += row[s] > m; ge += row[s] >= m; } if (gt >= 256 || ge < 256) bad = true;
            for (int j = 0; j < 256; ++j) for (int k = j + 1; k < 256; ++k) if (id[j] == id[k]) bad = true; } }
    if (bad) chk_fire(c, bit);
}
__device__ __forceinline__ void chk_qlat(const Params& p, const Ctx& c, unsigned bit) {
    const int gid = c.b * NTHR + c.tid; if (gid >= 8192) return;
    const bf16_t* proj = (const bf16_t*)(c.ws + WS_BIG + B_PROJ); const bf16_t* QL = (const bf16_t*)(c.ws + WS_QL);
    const unsigned h = (unsigned)gid * 2654435761u; const int row = (int)((h >> 8) % NTOK); const int col = (int)(((h * 40503u) >> 4) % 2048u); const int hh = col >> 8, r = col & 255;
    float a = 0.f; for (int d = 0; d < 128; ++d) a += bf2f(proj[(size_t)row * N_CDP + 2048 + hh * 128 + d]) * p.in[I_WUK][(size_t)r * 1024 + hh * 128 + d];
    a *= 0.08838834764831845f; const float got = bf2f(QL[(size_t)row * DM + col]);
    if (!(fabsf(got - a) <= 0.02f * fabsf(a) + 2e-3f)) chk_fire(c, bit);
}
__device__ __forceinline__ void chk_attn(const Params& p, const Ctx& c, unsigned bit) {
    const int gid = c.b * NTHR + c.tid; if (gid >= 2048) return;
    const bf16_t* QL = (const bf16_t*)(c.ws + WS_QL); const bf16_t* OL = (const bf16_t*)(c.ws + WS_BIG + B_OL); const bf16_t* C = (const bf16_t*)(c.ws + WS_C); const int* IDX = (const int*)(c.ws + WS_IDX);
    const unsigned h = (unsigned)gid * 2654435761u; const int row = gid < 64 ? NREAL + (gid & 15) : (int)((h >> 8) % NREAL); const int col = (int)(((h * 40503u) >> 4) % 2048u); const int hh = col >> 8, r = col & 255;
    float m = -INFINITY;
    for (int pass = 0; pass < 2; ++pass) { float sum = 0.f, o = 0.f;
        for (int j = 0; j < 272; ++j) { int k; bool valid;
            if (row >= NREAL) { valid = j <= row - NREAL; k = NREAL + j; } else if (j < 16) { valid = true; k = NREAL + j; } else { k = IDX[(size_t)row * 256 + j - 16]; valid = k >= 0; }
            if (!valid) continue;
            float s = 0.f; for (int d = 0; d < 256; ++d) s += bf2f(QL[(size_t)row * DM + hh * 256 + d]) * bf2f(C[(size_t)k * 256 + d]);
            if (pass == 0) m = fmaxf(m, s); else { const float e = expf(s - m); sum += e; o += e * bf2f(C[(size_t)k * 256 + r]); } }
        if (pass == 1) { const float ref = o / sum, got = bf2f(OL[(size_t)row * DM + col]); if (!(fabsf(got - ref) <= 0.03f * fabsf(ref) + 5e-3f)) chk_fire(c, bit); } }
}
__device__ __forceinline__ void chk_attproj(const Params& p, const Ctx& c, unsigned bit) {
    const int gid = c.b * NTHR + c.tid; if (gid >= 8192) return;
    const bf16_t* OL = (const bf16_t*)(c.ws + WS_BIG + B_OL); const bf16_t* MO = (const bf16_t*)(c.ws + WS_HN);
    const unsigned h = (unsigned)gid * 2654435761u; const int row = (int)((h >> 8) % NTOK); const int col = (int)(((h * 40503u) >> 4) % 1024u); const int hh = col >> 7, d = col & 127;
    float a = 0.f; for (int r = 0; r < 256; ++r) a += bf2f(OL[(size_t)row * DM + hh * 256 + r]) * p.in[I_WUV][(size_t)r * 1024 + hh * 128 + d];
    const float got = bf2f(MO[(size_t)row * DM + 1024 + col]);
    if (!(fabsf(got - a) <= 0.02f * fabsf(a) + 5e-3f)) chk_fire(c, bit);
}
__device__ __forceinline__ void chk_c(const Params& p, const Ctx& c, unsigned bit) {
    const int gid = c.b * NTHR + c.tid; if (gid >= 8192) return;
    const bf16_t* proj = (const bf16_t*)(c.ws + WS_BIG + B_PROJ); const bf16_t* C = (const bf16_t*)(c.ws + WS_C);
    const unsigned h = (unsigned)gid * 2654435761u; const int row = (int)((h >> 8) % NTOK); const int r = (int)(((h * 40503u) >> 4) % 256u);
    float ss = 0.f; for (int d = 0; d < 256; ++d) { const float v = bf2f(proj[(size_t)row * N_CDP + 3072 + d]); ss += v * v; }
    const float ref = bf2f(proj[(size_t)row * N_CDP + 3072 + r]) / sqrtf(ss / 256.0f + EPS) * p.in[I_KVN][r], got = bf2f(C[(size_t)row * 256 + r]);
    if (!(fabsf(got - ref) <= 0.02f * fabsf(ref) + 5e-3f)) chk_fire(c, bit);
}
#define CHK(x) x
#else
#define CHK(x)
#endif
template <int MODE>
__device__ __forceinline__ void meta_gemm(const Ctx& c, const bf16_t* A, int K, const bf16_t* Bt, int N, void* out, int ldo, int nmain, const float* rs) {
    LAS f32x4* red = (LAS f32x4*)c.lds;
    const int n = c.lane & 15, g = c.lane >> 4, ks = c.wave, kq = K / 8;
    const int nitems = (MODE == 2 ? N / 2 : N) / 16;
    const int rem = nmain % c.G, nlight = rem == 0 ? c.G : c.G - rem;
    const int myl = c.G - 1 - c.b; if (myl >= nlight) return;
    const bf16_t* ap = A + (size_t)(NREAL + n) * K + ks * kq + 8 * g;
    for (int it = myl; it < nitems; it += nlight) {
        const int ot = it;
        const int brow = MODE == 2 ? (ot >> 3) * 256 + (ot & 7) * 16 : ot * 16;
        const bf16_t* bp = Bt + (size_t)(brow + n) * K + ks * kq + 8 * g;
        f32x4 acc = (f32x4){0.f, 0.f, 0.f, 0.f}, acc2 = (f32x4){0.f, 0.f, 0.f, 0.f};
#pragma unroll 8
        for (int s = 0; s < kq / 32; ++s) { const bf16x8 a = *(const bf16x8*)(ap + 32 * s); const bf16x8 b = *(const bf16x8*)(bp + 32 * s);
            acc = __builtin_amdgcn_mfma_f32_16x16x32_bf16(b, a, acc, 0, 0, 0);
            if (MODE == 2) { const bf16x8 b2 = *(const bf16x8*)(bp + (size_t)128 * K + 32 * s); acc2 = __builtin_amdgcn_mfma_f32_16x16x32_bf16(b2, a, acc2, 0, 0, 0); } }
        red[c.wave * 64 + c.lane] = acc; if (MODE == 2) red[512 + c.wave * 64 + c.lane] = acc2;
        __syncthreads();
        if (c.wave == 0) {
            const float rsc = rs ? rs[NREAL + n] : 1.0f;
            f32x4 v = red[c.lane];
#pragma unroll
            for (int w_ = 1; w_ < 8; ++w_) v = v + red[w_ * 64 + c.lane];
            v = v * rsc;
            const size_t o = (size_t)(NREAL + n) * ldo + 16 * ot + 4 * g;
            if (MODE == 0) *(u32x2*)((bf16_t*)out + o) = (u32x2){pk2(v[0], v[1]), pk2(v[2], v[3])};
            if (MODE == 1) *(f32x4*)((float*)out + o) = v;
            if (MODE == 2) { f32x4 u = red[512 + c.lane];
#pragma unroll
                for (int w_ = 1; w_ < 8; ++w_) u = u + red[512 + w_ * 64 + c.lane];
                u = u * rsc;
                *(u32x2*)((bf16_t*)out + o) = (u32x2){pk2(siluf_(v[0]) * u[0], siluf_(v[1]) * u[1]), pk2(siluf_(v[2]) * u[2], siluf_(v[3]) * u[3])}; }
        }
        __syncthreads();
    }
}
__device__ __forceinline__ void convert_fill(const Params& p, const Ctx& c, int layer, int part, int nmain) {
    const int rem = nmain % c.G, nlight = rem == 0 ? c.G : c.G - rem; const int myl = c.G - 1 - c.b; if (myl >= nlight) return;
    phase_convert(p, c, layer, part, myl * NWAVES + c.wave, nlight * NWAVES);
}
constexpr int LDS_BYTES = 147456;
constexpr int NPHASE = 23;
__global__ void __launch_bounds__(NTHR, 2) mega(Params p, int ph_lo, int ph_hi) {
    extern __shared__ __attribute__((aligned(16))) unsigned char lds_raw[];
    cg::grid_group grid = cg::this_grid();
    { volatile LAS unsigned* misc_ = (volatile LAS unsigned*)((LAS unsigned char*)lds_raw + 147456 - 256); if (threadIdx.x < 16) misc_[threadIdx.x] = 0u; }
    __syncthreads();
    XcdBarrier xbar = xcd_barrier_post((unsigned*)(p.ws + WS_CTL + 4096), (volatile LAS unsigned*)((LAS unsigned char*)lds_raw + 147456 - 256));
    Ctx c; c.lds = (LAS unsigned char*)lds_raw; c.ws = p.ws; c.tid = threadIdx.x; c.lane = c.tid & 63; c.wave = __builtin_amdgcn_readfirstlane(c.tid >> 6); c.G = gridDim.x; c.b = blockIdx.x;
    const bf16_t* Tin = (const bf16_t*)(c.ws + WS_W + W_IN); const bf16_t* Tout = (const bf16_t*)(c.ws + WS_W + W_OUT); const bf16_t* T13 = (const bf16_t*)(c.ws + WS_W + W_13); const bf16_t* T2 = (const bf16_t*)(c.ws + WS_W + W_2);
    bf16_t* HN = (bf16_t*)(c.ws + WS_HN); const bf16_t* HB = (const bf16_t*)(c.ws + WS_H); const float* RSP = (const float*)(c.ws + WS_RS); bf16_t* PROJ = (bf16_t*)(c.ws + WS_BIG + B_PROJ); bf16_t* ACT = (bf16_t*)(c.ws + WS_BIG + B_ACT); float* Y = (float*)(c.ws + WS_BIG + B_Y);
#ifndef PHMASK
#define PHMASK 0x7fffff
#endif
#define RUNOK(k) (((PHMASK >> (k)) & 1) && ph_lo <= (k) && (k) < ph_hi)
#ifndef REPMASK
#define REPMASK 0
#define REPCOUNT 1
#endif
#define REPN(k) ((((REPMASK) >> (k)) & 1) ? (REPCOUNT) : 1)
#define PH(k) for (int rep_ = 0; rep_ < REPN(k); ++rep_, (rep_ < REPN(k) ? (xcd_barrier(xbar), 0) : 0)) if (RUNOK(k))
#define RUN(k) RUNOK(k)
#ifndef OUT_AFTER
#define OUT_AFTER 99
#endif
#define GSYNC() xcd_barrier(xbar)
#ifndef TPROBE
#define TPROBE -1
#endif
#ifndef TSCALE
#define TSCALE 4
#endif
#define SYNC(k) do { if (ph_lo <= (k) && (k) + 1 < ph_hi) { if (ph_lo < 0) grid.sync(); else GSYNC(); } FRESH(); \
    if (TPROBE >= 0 && blockIdx.x == 0 && threadIdx.x == 0) { if ((k) + 1 == TPROBE) ((unsigned long long*)(p.ws + WS_CTL + 1024))[0] = __builtin_amdgcn_s_memrealtime(); if ((k) == TPROBE) ((unsigned long long*)(p.ws + WS_CTL + 1024))[1] = __builtin_amdgcn_s_memrealtime(); } } while (0)
#define FRESH() do { int t_ = threadIdx.x; asm volatile("" : "+v"(t_)); c.tid = t_; c.lane = t_ & 63; c.wave = __builtin_amdgcn_readfirstlane(t_ >> 6); size_t z_ = 0; asm volatile("" : "+s"(z_)); c.ws = p.ws + z_; } while (0)
#define GEMM_BF16(Nn, Kk, Aa, Bb, Oo) do { pg8::Gemm g{Aa, Bb, NREAL, Nn, Kk}; pg8::StaticOrder S; S.init(NREAL, Nn, c.G, c.b); pg8::EpiBf16 E{Oo, Nn, RSP}; pg8::gemm_phase<pg8::EpiBf16, pg8::StaticOrder, true, true>(c.lds, g, S, E); meta_gemm<0>(c, Aa, Kk, Bb, Nn, Oo, Nn, (NREAL / 256) * (Nn / 256), RSP); } while (0)
#define GEMM_F32(Nn, Kk, Aa, Bb, Oo) do { pg8::Gemm g{Aa, Bb, NREAL, Nn, Kk}; pg8::StaticOrder S; S.init(NREAL, Nn, c.G, c.b); pg8::EpiBf16 E{(bf16_t*)(Oo), Nn, nullptr}; pg8::gemm_phase<pg8::EpiBf16, pg8::StaticOrder, true, true>(c.lds, g, S, E); meta_gemm<0>(c, Aa, Kk, Bb, Nn, (bf16_t*)(Oo), Nn, (NREAL / 256) * (Nn / 256), nullptr); } while (0)
#define GEMM_SWIGLU(Aa, Bb, Oo) do { pg8::Gemm g{Aa, Bb, NREAL, 2 * DFF, DM}; pg8::StaticOrder S; S.init(NREAL, 2 * DFF, c.G, c.b); pg8::EpiSwiglu E{Oo, DFF, RSP}; pg8::gemm_phase<pg8::EpiSwiglu, pg8::StaticOrder, true, true>(c.lds, g, S, E); meta_gemm<2>(c, Aa, DM, Bb, 2 * DFF, Oo, DFF, (NREAL / 256) * (2 * DFF / 256), RSP); } while (0)
    { constexpr int layer = 0;
        const int P = layer == 0 ? 0 : 9;
        if (layer == 0) {
            PH(0) { CHK(if (c.b == 0 && c.tid == 0) *(unsigned*)(c.ws + WS_CTL) = 0u;) phase_convert(p, c, 0, 0, c.b * NWAVES + c.wave, c.G * NWAVES); phase_norm0(p, c); }
            SYNC(0);
            PH(1) { GEMM_BF16(N_AB, DM, HB, Tin, PROJ); convert_fill(p, c, 0, 1, (NREAL / 256) * (N_AB / 256)); }
            SYNC(1);
            PH(2) { phase_hgrn<false>(p, c); sconv_part(p, c, 0, c.G); GSYNC(); phase_hgrn_scan(p, c); }
            SYNC(2);
            PH(3) phase_hgrn<true>(p, c);
            SYNC(3);
        } else {
            PH(9) { GEMM_BF16(N_CDP, DM, HB, Tin, PROJ); convert_fill(p, c, 1, 1, (NREAL / 256) * (N_CDP / 256)); }
            SYNC(9);
            PH(10) { }
            PH(11) {
#pragma nounroll
                for (int st_ = 0; st_ < 2; ++st_) { const bool sc_ = ((c.b & 1) != 0) == (st_ == 0);
                    if (sc_) phase_scores_v2(p, c); else { dsa_c_part(p, c); phase_gates_v2(p, c); bd_gemm<0>(p, c); }
                    FRESH(); } }
            SYNC(11);
            CHK(if (CHKSET == 2) chk_rg(p, c, 1u); if (CHKSET == 1) chk_rg(p, c, 4u);)
            PH(13) { if (c.wave < 4) rg_scan_s23(p, c); FRESH();
                { const int nseg_ = c.wave < 4 ? 1 : 2;
#pragma nounroll
                  for (int sg_ = 0; sg_ < nseg_; ++sg_) { const int klo_ = (c.wave >= 4 && sg_ == 1) ? 2 : 0, khi_ = (c.wave >= 4 && sg_ == 0) ? 2 : 8;
                      phase_select_v3(p, c, klo_, khi_); FRESH(); phase_attn_flash(p, c, klo_, khi_); FRESH(); } }
                if (c.wave >= 4) rg_scan_s23(p, c); }
            CHK(if (CHKSET == 0) chk_scores(p, c, 1u); if (CHKSET == 1) chk_c(p, c, 1u);)
            CHK(if (CHKSET == 0) { chk_select(p, c, 2u); grid.sync(); })
            PH(15) { }
            CHK(if (CHKSET == 0) chk_qlat(p, c, 4u);)
            SYNC(16);
            CHK(if (CHKSET == 0) chk_attn(p, c, 8u);)
            PH(17) bd_gemm<1>(p, c);
            SYNC(17);
        }
        const int Q = layer == 0 ? 4 : 18;
        CHK(if (layer == 1 && CHKSET == 1) chk_attproj(p, c, 2u);)
        PH(Q) GEMM_F32(DM, DM, HN, Tout, Y);
        SYNC(Q);
        CHK(if (layer == 1 && CHKSET == 2) { chk_gemm(c, HN, DM, DM, p.in[I_CD_OUT], DM, DM, Y, DM, false, 2u); } if (layer == 1) grid.sync();)
        PH(Q + 1) phase_normres(p, c, p.in[I_LN_MIX_POST] + layer * DM, p.in[I_LN_FFN_PRE] + layer * DM, false);
        SYNC(Q + 1);
        PH(Q + 2) { GEMM_SWIGLU(HB, T13, ACT); convert_fill(p, c, layer, 2, (NREAL / 256) * (2 * DFF / 256)); if (layer == 0) convert_fill(p, c, 1, 3, (NREAL / 256) * (2 * DFF / 256)); }
        SYNC(Q + 2);
        CHK(if (layer == 1 && CHKSET == 2) chk_swiglu(c, HN, p.in[I_W1] + (size_t)DM * DFF, p.in[I_W3] + (size_t)DM * DFF, ACT, 4u);)
        PH(Q + 3) GEMM_F32(DM, DFF, ACT, T2, Y);
        SYNC(Q + 3);
        PH(Q + 4) { if (layer == 0) { phase_normres(p, c, p.in[I_LN_FFN_POST], p.in[I_LN_MIX_PRE] + DM, false); phase_convert(p, c, 1, 0, c.b * NWAVES + c.wave, c.G * NWAVES); }
                          else { CHK(if (CHKSET == 2) chk_gemm(c, ACT, DFF, DFF, p.in[I_W2] + (size_t)DFF * DM, DM, DM, Y, DM, false, 4u);) phase_normres(p, c, p.in[I_LN_FFN_POST] + DM, nullptr, true); } }
        if (layer == 0) SYNC(Q + 4);
        (void)P;
    }
    { constexpr int layer = 1;
        const int P = layer == 0 ? 0 : 9;
        if (layer == 0) {
            PH(0) { CHK(if (c.b == 0 && c.tid == 0) *(unsigned*)(c.ws + WS_CTL) = 0u;) phase_convert(p, c, 0, 0, c.b * NWAVES + c.wave, c.G * NWAVES); phase_norm0(p, c); }
            SYNC(0);
            PH(1) { GEMM_BF16(N_AB, DM, HB, Tin, PROJ); convert_fill(p, c, 0, 1, (NREAL / 256) * (N_AB / 256)); }
            SYNC(1);
            PH(2) { phase_hgrn<false>(p, c); sconv_part(p, c, 0, c.G); GSYNC(); phase_hgrn_scan(p, c); }
            SYNC(2);
            PH(3) phase_hgrn<true>(p, c);
            SYNC(3);
        } else {
            PH(9) { GEMM_BF16(N_CDP, DM, HB, Tin, PROJ); convert_fill(p, c, 1, 1, (NREAL / 256) * (N_CDP / 256)); }
            SYNC(9);
            PH(10) { }
            PH(11) {
#pragma nounroll
                for (int st_ = 0; st_ < 2; ++st_) { const bool sc_ = ((c.b & 1) != 0) == (st_ == 0);
                    if (sc_) phase_scores_v2(p, c); else { dsa_c_part(p, c); phase_gates_v2(p, c); bd_gemm<0>(p, c); }
                    FRESH(); } }
            SYNC(11);
            CHK(if (CHKSET == 2) chk_rg(p, c, 1u); if (CHKSET == 1) chk_rg(p, c, 4u);)
            PH(13) { if (c.wave < 4) rg_scan_s23(p, c); FRESH();
                { const int nseg_ = c.wave < 4 ? 1 : 2;
#pragma nounroll
                  for (int sg_ = 0; sg_ < nseg_; ++sg_) { const int klo_ = (c.wave >= 4 && sg_ == 1) ? 2 : 0, khi_ = (c.wave >= 4 && sg_ == 0) ? 2 : 8;
                      phase_select_v3(p, c, klo_, khi_); FRESH(); phase_attn_flash(p, c, klo_, khi_); FRESH(); } }
                if (c.wave >= 4) rg_scan_s23(p, c); }
            CHK(if (CHKSET == 0) chk_scores(p, c, 1u); if (CHKSET == 1) chk_c(p, c, 1u);)
            CHK(if (CHKSET == 0) { chk_select(p, c, 2u); grid.sync(); })
            PH(15) { }
            CHK(if (CHKSET == 0) chk_qlat(p, c, 4u);)
            SYNC(16);
            CHK(if (CHKSET == 0) chk_attn(p, c, 8u);)
            PH(17) bd_gemm<1>(p, c);
            SYNC(17);
        }
        const int Q = layer == 0 ? 4 : 18;
        CHK(if (layer == 1 && CHKSET == 1) chk_attproj(p, c, 2u);)
        PH(Q) GEMM_F32(DM, DM, HN, Tout, Y);
        SYNC(Q);
        CHK(if (layer == 1 && CHKSET == 2) { chk_gemm(c, HN, DM, DM, p.in[I_CD_OUT], DM, DM, Y, DM, false, 2u); } if (layer == 1) grid.sync();)
        PH(Q + 1) phase_normres(p, c, p.in[I_LN_MIX_POST] + layer * DM, p.in[I_LN_FFN_PRE] + layer * DM, false);
        SYNC(Q + 1);
        PH(Q + 2) { GEMM_SWIGLU(HB, T13, ACT); convert_fill(p, c, layer, 2, (NREAL / 256) * (2 * DFF / 256)); if (layer == 0) convert_fill(p, c, 1, 3, (NREAL / 256) * (2 * DFF / 256)); }
        SYNC(Q + 2);
        CHK(if (layer == 1 && CHKSET == 2) chk_swiglu(c, HN, p.in[I_W1] + (size_t)DM * DFF, p.in[I_W3] + (size_t)DM * DFF, ACT, 4u);)
        PH(Q + 3) GEMM_F32(DM, DFF, ACT, T2, Y);
        SYNC(Q + 3);
        PH(Q + 4) { if (layer == 0) { phase_normres(p, c, p.in[I_LN_FFN_POST], p.in[I_LN_MIX_PRE] + DM, false); phase_convert(p, c, 1, 0, c.b * NWAVES + c.wave, c.G * NWAVES); }
                          else { CHK(if (CHKSET == 2) chk_gemm(c, ACT, DFF, DFF, p.in[I_W2] + (size_t)DFF * DM, DM, DM, Y, DM, false, 4u);) phase_normres(p, c, p.in[I_LN_FFN_POST] + DM, nullptr, true); } }
        if (layer == 0) SYNC(Q + 4);
        (void)P;
    }
    if (TPROBE >= 0) {
        GSYNC();
        const unsigned long long* tp_ = (const unsigned long long*)(p.ws + WS_CTL + 1024); const unsigned long long d_ = tp_[1] - tp_[0];
        const int R_ = (int)min((unsigned long long)NREAL, d_ * TSCALE / 100ull);
        f32x4* od_ = (f32x4*)p.out; for (int i_ = c.b * NTHR + c.tid; i_ < R_ * (DM / 4); i_ += c.G * NTHR) od_[i_] = (f32x4){0.f, 0.f, 0.f, 0.f};
    }
#ifdef CHECKS
    grid.sync();
    unsigned fl = *(volatile unsigned*)(c.ws + WS_CTL);
    { f32x4* od_ = (f32x4*)p.out;
      for (int i_ = c.b * NTHR + c.tid; i_ < NREAL * DM / 4; i_ += c.G * NTHR) { const int r_ = i_ / (DM / 4);
          const bool z = ((fl & 1u) && r_ < 512) || ((fl & 2u) && r_ >= 512 && r_ < 1536) || ((fl & 4u) && r_ >= 1536 && r_ < 3584) || ((fl & 8u) && r_ >= 3584 && r_ < 7680);
          if (z) od_[i_] = (f32x4){0.f, 0.f, 0.f, 0.f}; } }
#endif
}

extern "C" void kernel_launch(void* const* d_in, const int* in_sizes, int n_in, void* d_out, int out_size, void* d_ws, size_t ws_size, hipStream_t stream) {
    static int grid = 0;
    if (grid == 0) {
        int dev = 0, cus = 0, per_cu = 0;
        hipGetDevice(&dev); hipDeviceGetAttribute(&cus, hipDeviceAttributeMultiprocessorCount, dev);
        hipFuncSetAttribute((const void*)mega, hipFuncAttributeMaxDynamicSharedMemorySize, LDS_BYTES);
        hipOccupancyMaxActiveBlocksPerMultiprocessor(&per_cu, (const void*)mega, NTHR, LDS_BYTES);
        if (per_cu < 1) { fprintf(stderr, "kernel_launch: occupancy query says %d blocks per CU\n", per_cu); per_cu = 1; }
        grid = cus;
        if (ws_size < WS_END) fprintf(stderr, "kernel_launch: workspace %zu < %zu needed\n", ws_size, (size_t)WS_END);
        if (n_in != 26) fprintf(stderr, "kernel_launch: expected 26 inputs, got %d\n", n_in);
    }
    hipMemsetAsync((char*)d_ws + WS_CTL, 0, 65536, stream);
    Params p{};
    for (int i = 0; i < 26; ++i) p.in[i] = (const float*)d_in[i];
    p.out = (float*)d_out; p.ws = (unsigned char*)d_ws;
    int lo = 0, hi = NPHASE;
    void* args[] = {&p, &lo, &hi};
    hipError_t e = hipLaunchCooperativeKernel((const void*)mega, dim3(grid), dim3(NTHR), args, LDS_BYTES, stream);
    if (e != hipSuccess) fprintf(stderr, "cooperative launch failed: %s (grid %d)\n", hipGetErrorString(e), grid);
}
```
